# Optimizing an MI355X kernel written in HIP

```python
import math
import jax, jax.numpy as jnp
from jax import lax
import numpy as np

D_MODEL = 1024
BATCH = 16
SEQ = 256
DEPTH = 4
DEC_BATCH = 2
DEC_SEQ = 1024
PAST_LEN = 256

GRID_W = 64
CHUNK = 128
N_GROUPS_A = 4
D_A = D_MODEL
N_HEADS = 8
HEAD_DIM = D_MODEL // (2 * N_HEADS)
V_DIM = 2 * HEAD_DIM
ATTN_W = N_HEADS * V_DIM
D_FF = ((8 * D_MODEL // 3 + 127) // 128) * 128
IN_W = 2 * D_A + 3 * ATTN_W + 2 * D_MODEL
N_MOD = 9
ROPE_THETA = 10000.0
Q_BLOCK = 128
EPS = 1e-6

kernel_name = 'hybrid_dit_gmlp_diffattn_step'


def rmsnorm(x, g):
    xf = x.astype(jnp.float32)
    r = lax.rsqrt(jnp.mean(xf * xf, axis=-1, keepdims=True) + EPS)
    return (xf * r).astype(x.dtype) * g


def swiglu(h, w13, w2):
    gate, up = jnp.split(h @ w13, 2, axis=-1)
    return (jax.nn.silu(gate) * up) @ w2


def spatial_gating(z, v_gain, w_s, b_s):
    u, v = jnp.split(z, 2, axis=-1)
    v = rmsnorm(v, v_gain)
    B, N, _ = v.shape
    vc = v.reshape(B, N // CHUNK, CHUNK, N_GROUPS_A, D_A // N_GROUPS_A)
    mixed = jnp.einsum('gpq,bnqgc->bnpgc', w_s, vc) + jnp.swapaxes(b_s, 0, 1)[:, :, None]
    return u * mixed.reshape(B, N, D_A)


def rope_half(x, ang):
    cos = jnp.cos(ang)[None, :, None, None, :].astype(x.dtype)
    sin = jnp.sin(ang)[None, :, None, None, :].astype(x.dtype)
    x1, x2 = jnp.split(x, 2, axis=-1)
    return jnp.concatenate([x1 * cos - x2 * sin, x2 * cos + x1 * sin], axis=-1)


def axial_rope(x):
    n = x.shape[1]
    n_rows = n // GRID_W
    row = jnp.repeat(jnp.arange(n_rows, dtype=jnp.float32), GRID_W)
    col = jnp.tile(jnp.arange(GRID_W, dtype=jnp.float32), n_rows)
    half = HEAD_DIM // 2
    freqs = ROPE_THETA ** (-jnp.arange(0, half, 2, dtype=jnp.float32) / half)
    xr = rope_half(x[..., :half], row[:, None] * freqs[None, :])
    xc = rope_half(x[..., half:], col[:, None] * freqs[None, :])
    return jnp.concatenate([xr, xc], axis=-1)


def diff_attention(q, k, v, lam):
    B, Nq = q.shape[0], q.shape[1]
    nb = Nq // Q_BLOCK
    qb = jnp.swapaxes(q.reshape(B, nb, Q_BLOCK, N_HEADS, 2, HEAD_DIM), 0, 1)
    scale = HEAD_DIM ** -0.5

    def block(qi):
        s = jnp.einsum('bqhid,bkhid->bihqk', qi, k).astype(jnp.float32) * scale
        p = jax.nn.softmax(s, axis=-1)
        a = p[:, 0] - lam * p[:, 1]
        return jnp.einsum('bhqk,bkhe->bqhe', a.astype(v.dtype), v)

    out = lax.map(block, qb)
    return jnp.swapaxes(out, 0, 1).reshape(B, Nq, N_HEADS, V_DIM)


def setup_inputs(seed: int = 0) -> dict:
    key = jax.random.key(seed)
    ks = jax.random.split(key, 32)
    f32 = jnp.float32

    def nrm(k, shape, scale):
        return jax.random.normal(k, shape, f32) * scale

    def gain(k, shape):
        return 1.0 + 0.01 * jax.random.normal(k, shape, f32)

    return {
        'x_prompt': nrm(ks[0], (BATCH, SEQ, D_MODEL), 1.0),
        'x_sample': nrm(ks[1], (DEC_BATCH, DEC_SEQ, D_MODEL), 1.0),
        'cache_k': nrm(ks[2], (DEC_BATCH, DEPTH, PAST_LEN, N_HEADS, 2 * HEAD_DIM), 1.0),
        'cache_v': nrm(ks[3], (DEC_BATCH, DEPTH, PAST_LEN, N_HEADS, V_DIM), 1.0),
        'c': nrm(ks[4], (DEC_BATCH, D_MODEL), 1.0),
        'c_ctx': nrm(ks[5], (D_MODEL,), 1.0),
        'w_mod': nrm(ks[6], (DEPTH, D_MODEL, N_MOD * D_MODEL), 0.5 * D_MODEL ** -0.5),
        'b_mod': nrm(ks[7], (DEPTH, N_MOD * D_MODEL), 0.01),
        'g_norm': gain(ks[8], (DEPTH, 3, D_MODEL)),
        'ffn1_w13': nrm(ks[9], (DEPTH, D_MODEL, 2 * D_FF), D_MODEL ** -0.5),
        'ffn1_w2': nrm(ks[10], (DEPTH, D_FF, D_MODEL), D_FF ** -0.5),
        'w_in': nrm(ks[11], (DEPTH, D_MODEL, IN_W), D_MODEL ** -0.5),
        'sgu_gain': gain(ks[12], (DEPTH, D_A)),
        'w_spatial': nrm(ks[13], (DEPTH, N_GROUPS_A, CHUNK, CHUNK), CHUNK ** -0.5),
        'b_spatial': gain(ks[14], (DEPTH, N_GROUPS_A, CHUNK)),
        'lam': nrm(ks[15], (DEPTH, 4, HEAD_DIM), 0.1),
        'subln_gain': gain(ks[16], (DEPTH, V_DIM)),
        'w_branch_a': nrm(ks[17], (DEPTH, D_A, D_MODEL), D_A ** -0.5),
        'w_branch_b': nrm(ks[18], (DEPTH, ATTN_W, D_MODEL), ATTN_W ** -0.5),
        'w_out': nrm(ks[19], (DEPTH, D_MODEL, D_MODEL), D_MODEL ** -0.5),
        'ffn2_w13': nrm(ks[20], (DEPTH, D_MODEL, 2 * D_FF), D_MODEL ** -0.5),
        'ffn2_w2': nrm(ks[21], (DEPTH, D_FF, D_MODEL), D_FF ** -0.5),
        'g_final': gain(ks[22], (D_MODEL,)),
    }


def reference(x_prompt, x_sample, cache_k, cache_v, c, c_ctx, w_mod, b_mod, g_norm,
              ffn1_w13, ffn1_w2, w_in, sgu_gain, w_spatial, b_spatial, lam, subln_gain,
              w_branch_a, w_branch_b, w_out, ffn2_w13, ffn2_w2, g_final):

    def mixer(h, l, ctx_kv, use_rope):
        B, N, _ = h.shape
        proj = h @ w_in[l]
        z, q, k, v, gates = jnp.split(
            proj, [2 * D_A, 2 * D_A + ATTN_W, 2 * D_A + 2 * ATTN_W, 2 * D_A + 3 * ATTN_W], axis=-1)
        a = spatial_gating(jax.nn.gelu(z), sgu_gain[l], w_spatial[l], b_spatial[l])
        q = q.reshape(B, N, N_HEADS, 2, HEAD_DIM)
        k = k.reshape(B, N, N_HEADS, 2, HEAD_DIM)
        v = v.reshape(B, N, N_HEADS, V_DIM)
        k_state = k.reshape(B, N, N_HEADS, 2 * HEAD_DIM)
        v_state = v
        if use_rope:
            q = axial_rope(q)
            k = axial_rope(k)
        if ctx_kv is not None:
            ck, cv = ctx_kv
            k = jnp.concatenate([ck.reshape(B, ck.shape[1], N_HEADS, 2, HEAD_DIM), k], axis=1)
            v = jnp.concatenate([cv, v], axis=1)
        lam_init = 0.8 - 0.6 * math.exp(-0.3 * l)
        lp = lam[l].astype(jnp.float32)
        lam_full = jnp.exp(jnp.sum(lp[0] * lp[1])) - jnp.exp(jnp.sum(lp[2] * lp[3])) + lam_init
        o = diff_attention(q, k, v, lam_full)
        o = rmsnorm(o, subln_gain[l]) * (1.0 - lam_init)
        b = o.reshape(B, N, ATTN_W)
        g_a, g_b = jnp.split(gates, 2, axis=-1)
        merged = jax.nn.sigmoid(g_a) * (a @ w_branch_a[l]) + jax.nn.sigmoid(g_b) * (b @ w_branch_b[l])
        return merged @ w_out[l], k_state, v_state

    def run_layer(x, cond, l, ctx_kv, use_rope):
        mod = jax.nn.silu(cond) @ w_mod[l] + b_mod[l]
        sh1, sc1, gt1, sh2, sc2, gt2, sh3, sc3, gt3 = jnp.split(mod, N_MOD, axis=-1)
        h = rmsnorm(x, g_norm[l, 0]) * (1.0 + sc1) + sh1
        x = x + 0.5 * gt1 * swiglu(h, ffn1_w13[l], ffn1_w2[l])
        h = rmsnorm(x, g_norm[l, 1]) * (1.0 + sc2) + sh2
        m, k_state, v_state = mixer(h, l, ctx_kv, use_rope)
        x = x + gt2 * m
        h = rmsnorm(x, g_norm[l, 2]) * (1.0 + sc3) + sh3
        x = x + 0.5 * gt3 * swiglu(h, ffn2_w13[l], ffn2_w2[l])
        return x, k_state, v_state

    xp = x_prompt
    k_list, v_list = [], []
    for l in range(DEPTH):
        xp, k_l, v_l = run_layer(xp, c_ctx, l, None, False)
        k_list.append(k_l)
        v_list.append(v_l)
    y_prompt = rmsnorm(xp, g_final)
    new_cache_k = jnp.stack(k_list, axis=1)
    new_cache_v = jnp.stack(v_list, axis=1)

    xs = x_sample
    cond = c[:, None, :]
    for l in range(DEPTH):
        xs, _, _ = run_layer(xs, cond, l, (cache_k[:, l], cache_v[:, l]), True)
    y_sample = rmsnorm(xs, g_final)

    return (y_prompt, y_sample, new_cache_k, new_cache_v)
```

```cpp
#include <hip/hip_runtime.h>
#include <hip/hip_cooperative_groups.h>
#include <cstdio>
#include <cstdint>
namespace cg = cooperative_groups;

#ifndef COOP
#define COOP 1
#endif

typedef unsigned short bf16_t;
typedef short bf16x8 __attribute__((ext_vector_type(8)));
typedef short s16x4 __attribute__((ext_vector_type(4)));
typedef float f32x4 __attribute__((ext_vector_type(4)));
typedef float f32x2 __attribute__((ext_vector_type(2)));
typedef __bf16 bf16x2_t __attribute__((ext_vector_type(2)));
typedef unsigned u32x2 __attribute__((ext_vector_type(2)));
typedef unsigned u32x4 __attribute__((ext_vector_type(4)));

#define DI __device__ __forceinline__

constexpr int R = 6144;
constexpr int RC = 4096;
constexpr int D = 1024;
constexpr int DFF = 2816;
constexpr int INW = 7168;
constexpr int NTHR = 512;
constexpr int LDS_X = 147456;
constexpr int LDS_BYTES = LDS_X + 1024;
constexpr float EPS = 1e-6f;

constexpr size_t al(size_t x) { return (x + 255) & ~(size_t)255; }
constexpr size_t O_X = 0;
constexpr size_t O_H = al(O_X + (size_t)R * D * 4);
constexpr size_t O_ACT = al(O_H + (size_t)R * D * 2);
constexpr size_t O_U = al(O_ACT + (size_t)R * DFF * 2);
constexpr size_t O_VT = al(O_U + (size_t)R * D * 2);
constexpr size_t O_VSS = al(O_VT + (size_t)R * D * 2);
constexpr size_t O_Q = al(O_VSS + (size_t)R * 16 * 4);
constexpr size_t O_KC = al(O_Q + (size_t)R * D * 2);
constexpr size_t O_KL = al(O_KC + (size_t)RC * D * 2);
constexpr size_t O_VTC = al(O_KL + (size_t)8 * 1280 * D * 2);
constexpr size_t O_VTL = al(O_VTC + (size_t)16 * 8 * 128 * 256 * 2);
constexpr size_t O_SG = al(O_VTL + (size_t)8 * 8 * 128 * 1280 * 2);
constexpr size_t O_ABR = al(O_SG + (size_t)R * 2048 * 2);
constexpr size_t O_BBR = al(O_ABR + (size_t)R * D * 2);
constexpr size_t O_MG = al(O_BBR + (size_t)R * D * 2);
constexpr size_t O_MG1 = al(O_MG + (size_t)R * D * 2);
constexpr size_t O_MOD = al(O_MG1 + (size_t)R * D * 4);
constexpr size_t O_ROPE = al(O_MOD + (size_t)4 * 3 * 9216 * 4);
constexpr size_t O_W = al(O_ROPE + 8192 + 256);
constexpr size_t WE_13A = 0;
constexpr size_t WE_2A = WE_13A + (size_t)5632 * 1024;
constexpr size_t WE_IN = WE_2A + (size_t)1024 * 2816;
constexpr size_t WE_A = WE_IN + (size_t)7168 * 1024;
constexpr size_t WE_B = WE_A + (size_t)1024 * 1024;
constexpr size_t WE_O = WE_B + (size_t)1024 * 1024;
constexpr size_t WE_13B = WE_O + (size_t)1024 * 1024;
constexpr size_t WE_2B = WE_13B + (size_t)5632 * 1024;
constexpr size_t WE_LAYER = WE_2B + (size_t)1024 * 2816;
constexpr size_t O_BAR = al(O_W + WE_LAYER * 4 * 2);
constexpr size_t WS_END = O_BAR + 16384;

struct Params {
    const float* in[23];
    float* out;
    unsigned char* ws;
    int ph_lo, ph_hi;
};

DI unsigned pk(float a, float b) { f32x2 v = {a, b}; bf16x2_t r = __builtin_convertvector(v, bf16x2_t); return __builtin_bit_cast(unsigned, r); }
DI float bf2f(bf16_t v) { return __uint_as_float(((unsigned)v) << 16); }
DI float bfround(float a) { unsigned u = pk(a, 0.f); return __uint_as_float(u << 16); }
DI float fexp2(float x) { return __builtin_amdgcn_exp2f(x); }
DI float fexp(float x) { return __builtin_amdgcn_exp2f(x * 1.44269504089f); }
DI float frcp(float x) { return __builtin_amdgcn_rcpf(x); }
DI float sigmoidf_(float x) { return frcp(1.f + fexp(-x)); }
DI float siluf_(float x) { return x * sigmoidf_(x); }
DI float geluf_(float x) { float u = 0.7978845608f * (x + 0.044715f * x * x * x); return x * frcp(1.f + fexp(-2.f * u)); }
DI int otid() { int t = threadIdx.x; asm volatile("" : "+v"(t)); return t; }
DI int cond_of_row(int row) { return row < RC ? 0 : 1 + ((row - RC) >> 10); }

DI int lds_byte(int r, int c) { const int st = (r >> 4) * 2 + (c >> 5), rr = r & 15, cc = c & 31, ob = rr * 64 + cc * 2; return st * 1024 + (ob ^ (((ob >> 9) & 1) << 5)); }
DI void stage_rc(int b, int& Rr, int& Cc) { const int st = b / 1024, sb = b % 1024, swz = sb ^ (((sb >> 9) & 1) << 5); Rr = (st >> 1) * 16 + swz / 64; Cc = (st & 1) * 32 + (swz % 64) / 2; }

DI void glds16(const void* g, void* l) { __builtin_amdgcn_global_load_lds((const unsigned*)g, (unsigned*)l, 16, 0, 0); }
#define WAIT_VM0() asm volatile("s_waitcnt vmcnt(0)" ::: "memory")

template <int NI = 4>
DI void stage_half(unsigned char* buf, const bf16_t* src, int ld, int tid) {
#pragma unroll
    for (int i = 0; i < NI; ++i) {
        const int b = tid * 16 + i * 8192; int r, c; stage_rc(b, r, c);
        glds16(src + (size_t)r * ld + c, buf + b);
    }
}

#define LDS_RD(dst, base, off) asm volatile("ds_read_b128 %0, %1 offset:" #off : "=v"(dst) : "v"(base) : "memory")
template <int MI>
DI void compute_ktile(unsigned sa, unsigned sb, f32x4 (&acc)[MI][4]) {
    bf16x8 af[2][4], bw[2][4];
    LDS_RD(af[0][0], sa, 0); if (MI > 1) LDS_RD(af[0][1], sa, 2048); if (MI > 2) LDS_RD(af[0][2], sa, 4096); if (MI > 3) LDS_RD(af[0][3], sa, 6144);
    LDS_RD(bw[0][0], sb, 0); LDS_RD(bw[0][1], sb, 2048); LDS_RD(bw[0][2], sb, 4096); LDS_RD(bw[0][3], sb, 6144);
    LDS_RD(af[1][0], sa, 1024); if (MI > 1) LDS_RD(af[1][1], sa, 3072); if (MI > 2) LDS_RD(af[1][2], sa, 5120); if (MI > 3) LDS_RD(af[1][3], sa, 7168);
    LDS_RD(bw[1][0], sb, 1024); LDS_RD(bw[1][1], sb, 3072); LDS_RD(bw[1][2], sb, 5120); LDS_RD(bw[1][3], sb, 7168);
    __builtin_amdgcn_sched_barrier(0);
    if (MI == 4) asm volatile("s_waitcnt lgkmcnt(8)" ::: "memory"); else if (MI == 3) asm volatile("s_waitcnt lgkmcnt(7)" ::: "memory"); else if (MI == 2) asm volatile("s_waitcnt lgkmcnt(6)" ::: "memory"); else asm volatile("s_waitcnt lgkmcnt(5)" ::: "memory");
    __builtin_amdgcn_sched_barrier(0);
#pragma unroll
    for (int m = 0; m < MI; ++m)
#pragma unroll
        for (int n = 0; n < 4; ++n) acc[m][n] = __builtin_amdgcn_mfma_f32_16x16x32_bf16(bw[0][n], af[0][m], acc[m][n], 0, 0, 0);
    __builtin_amdgcn_sched_barrier(0);
    asm volatile("s_waitcnt lgkmcnt(0)" ::: "memory");
    __builtin_amdgcn_sched_barrier(0);
#pragma unroll
    for (int m = 0; m < MI; ++m)
#pragma unroll
        for (int n = 0; n < 4; ++n) acc[m][n] = __builtin_amdgcn_mfma_f32_16x16x32_bf16(bw[1][n], af[1][m], acc[m][n], 0, 0, 0);
    __builtin_amdgcn_sched_barrier(0);
}
DI unsigned lds_addr(const void* p) { return (unsigned)(uintptr_t)(const __attribute__((address_space(3))) unsigned char*)p; }

template <int MI>
DI void gemm_tile(const bf16_t* A, int lda, const bf16_t* Bt, int ldb, int K, int m0, int n0, f32x4 (&acc)[MI][4], unsigned char* lds) {
    const int tid = otid(), wid = tid >> 6, lane = tid & 63, wr = wid >> 1, wc = wid & 1, fr = lane & 15, fq = lane >> 4;
#pragma unroll
    for (int m = 0; m < MI; ++m)
#pragma unroll
        for (int n = 0; n < 4; ++n) acc[m][n] = (f32x4){0.f, 0.f, 0.f, 0.f};
    const bf16_t* Ab = A + (size_t)m0 * lda;
    const bf16_t* Bb = Bt + (size_t)n0 * ldb;
    const int nt = K >> 6;
    const unsigned la = lds_addr(lds) + lds_byte(wr * (MI * 16) + fr, fq * 8), lb = lds_addr(lds) + 32768 + lds_byte(wc * 64 + fr, fq * 8);
    __syncthreads();
    stage_half<MI>(lds, Ab, lda, tid);
    stage_half<2>(lds + 32768, Bb, ldb, tid);
    stage_half<MI>(lds + 49152, Ab + 64, lda, tid);
    stage_half<2>(lds + 49152 + 32768, Bb + 64, ldb, tid);
    int cur = 0, nxt = 2;
    for (int t = 0; t < nt; ++t) {
        if (t + 1 < nt) { if (MI == 4) asm volatile("s_waitcnt vmcnt(6)" ::: "memory"); else if (MI == 3) asm volatile("s_waitcnt vmcnt(5)" ::: "memory"); else if (MI == 2) asm volatile("s_waitcnt vmcnt(4)" ::: "memory"); else asm volatile("s_waitcnt vmcnt(3)" ::: "memory"); }
        else asm volatile("s_waitcnt vmcnt(0)" ::: "memory");
        __builtin_amdgcn_sched_barrier(0);
        asm volatile("" ::: "memory");
        __builtin_amdgcn_s_barrier();
        asm volatile("" ::: "memory");
        __builtin_amdgcn_sched_barrier(0);
        if (t + 2 < nt) {
            stage_half<MI>(lds + nxt * 49152, Ab + (t + 2) * 64, lda, tid);
            stage_half<2>(lds + nxt * 49152 + 32768, Bb + (t + 2) * 64, ldb, tid);
        }
        compute_ktile<MI>(la + cur * 49152, lb + cur * 49152, acc);
        cur = (cur == 2) ? 0 : cur + 1; nxt = (nxt == 2) ? 0 : nxt + 1;
    }
}

DI void store_bf4(bf16_t* p, f32x4 v) { u32x2 w; w.x = pk(v[0], v[1]); w.y = pk(v[2], v[3]); *(u32x2*)p = w; }

DI void transpose_tile(const float* __restrict__ src, int ld_src, bf16_t* __restrict__ dst, int ld_dst, int k0, int r0, int perm, float* tile_base) {
    const int tid = otid(), lt = tid & 255;
    float* tile = tile_base + (tid >> 8) * (64 * 65);
    const int ty = lt >> 4, tx = lt & 15, nn = tx * 4;
    const int scol = perm ? ((nn >> 5) * DFF + (r0 >> 7) * 64 + ((r0 >> 6) & 1) * 32 + (nn & 31)) : (r0 + nn);
    __syncthreads();
#pragma unroll
    for (int i = 0; i < 4; ++i) {
        const int kk = ty + 16 * i;
        const f32x4 v = __builtin_nontemporal_load((const f32x4*)(src + (size_t)(k0 + kk) * ld_src + scol));
        tile[kk * 65 + nn + 0] = v[0]; tile[kk * 65 + nn + 1] = v[1]; tile[kk * 65 + nn + 2] = v[2]; tile[kk * 65 + nn + 3] = v[3];
    }
    __syncthreads();
    const int n = lt >> 2, kc = lt & 3;
    u32x4 w0, w1;
    w0.x = pk(tile[(kc * 16 + 0) * 65 + n], tile[(kc * 16 + 1) * 65 + n]);
    w0.y = pk(tile[(kc * 16 + 2) * 65 + n], tile[(kc * 16 + 3) * 65 + n]);
    w0.z = pk(tile[(kc * 16 + 4) * 65 + n], tile[(kc * 16 + 5) * 65 + n]);
    w0.w = pk(tile[(kc * 16 + 6) * 65 + n], tile[(kc * 16 + 7) * 65 + n]);
    w1.x = pk(tile[(kc * 16 + 8) * 65 + n], tile[(kc * 16 + 9) * 65 + n]);
    w1.y = pk(tile[(kc * 16 + 10) * 65 + n], tile[(kc * 16 + 11) * 65 + n]);
    w1.z = pk(tile[(kc * 16 + 12) * 65 + n], tile[(kc * 16 + 13) * 65 + n]);
    w1.w = pk(tile[(kc * 16 + 14) * 65 + n], tile[(kc * 16 + 15) * 65 + n]);
    u32x4* d = (u32x4*)(dst + (size_t)(r0 + n) * ld_dst + k0 + kc * 16);
    d[0] = w0; d[1] = w1;
}

__device__ void phase_prologue(const Params& p, unsigned char* lds) {
    const int tid = otid();
    float* tile = (float*)lds;
    bf16_t* W = (bf16_t*)(p.ws + O_W);
    constexpr int NT_W = 27136 / 2, NT_MOD = 576, NT_CK = 512, NT_CV = 512 / 2, NT_X = 768;
    constexpr int TOTAL = NT_W + NT_MOD + NT_CK + NT_CV + NT_X + 1;
    for (int it = blockIdx.x; it < TOTAL; it += gridDim.x) {
        if (it < NT_W) {
            const int it2 = it * 2 + (tid >> 8);
            const int l = it2 / 6784, r = it2 % 6784;
            int widx, ti;
            if (r < 1408) { widx = 0; ti = r; } else if (r < 2112) { widx = 1; ti = r - 1408; } else if (r < 3904) { widx = 2; ti = r - 2112; }
            else if (r < 4160) { widx = 3; ti = r - 3904; } else if (r < 4416) { widx = 4; ti = r - 4160; } else if (r < 4672) { widx = 5; ti = r - 4416; }
            else if (r < 6080) { widx = 6; ti = r - 4672; } else { widx = 7; ti = r - 6080; }
            const float* src; int K, N, perm = 0; size_t we;
            switch (widx) {
                case 0: src = p.in[9]; K = 1024; N = 5632; perm = 1; we = WE_13A; break;
                case 1: src = p.in[10]; K = 2816; N = 1024; we = WE_2A; break;
                case 2: src = p.in[11]; K = 1024; N = 7168; we = WE_IN; break;
                case 3: src = p.in[17]; K = 1024; N = 1024; we = WE_A; break;
                case 4: src = p.in[18]; K = 1024; N = 1024; we = WE_B; break;
                case 5: src = p.in[19]; K = 1024; N = 1024; we = WE_O; break;
                case 6: src = p.in[20]; K = 1024; N = 5632; perm = 1; we = WE_13B; break;
                default: src = p.in[21]; K = 2816; N = 1024; we = WE_2B; break;
            }
            const int nkt = K >> 6;
            const int nrt = N >> 6;
            const int rt = ti % nrt, kt = ti / nrt;
            transpose_tile(src + (size_t)l * K * N, N, W + (size_t)l * WE_LAYER + we, K, kt * 64, rt * 64, perm, tile);
        } else if (it < NT_W + NT_MOD) {
            const int j = it - NT_W, l = j / 144, cb = j % 144;
            const int tx = tid & 15, kg = tid >> 4;
            const float* wm = p.in[6] + (size_t)l * 1024 * 9216 + cb * 64 + tx * 4;
            f32x4 a0 = {0.f, 0.f, 0.f, 0.f}, a1 = a0, a2 = a0;
#pragma unroll 8
            for (int k = kg; k < 1024; k += 32) {
                const f32x4 w = __builtin_nontemporal_load((const f32x4*)(wm + (size_t)k * 9216));
                const float s0 = siluf_(p.in[5][k]), s1 = siluf_(p.in[4][k]), s2 = siluf_(p.in[4][1024 + k]);
                a0 += w * s0; a1 += w * s1; a2 += w * s2;
            }
            __syncthreads();
            float* red = tile;
#pragma unroll
            for (int q = 0; q < 4; ++q) { red[(kg * 3 + 0) * 64 + tx * 4 + q] = a0[q]; red[(kg * 3 + 1) * 64 + tx * 4 + q] = a1[q]; red[(kg * 3 + 2) * 64 + tx * 4 + q] = a2[q]; }
            __syncthreads();
            if (tid < 192) {
                const int c = tid >> 6, col = tid & 63;
                float s = 0.f;
#pragma unroll
                for (int g = 0; g < 32; ++g) s += red[(g * 3 + c) * 64 + col];
                const int jc = cb * 64 + col;
                ((float*)(p.ws + O_MOD))[(size_t)(l * 3 + c) * 9216 + jc] = s + p.in[7][l * 9216 + jc];
            }
        } else if (it < NT_W + NT_MOD + NT_CK) {
            const int j = it - NT_W - NT_MOD;
            const size_t e0 = (size_t)j * 4096 + tid * 8;
            const int col = (int)(e0 & 1023), key = (int)((e0 >> 10) & 255), bl = (int)(e0 >> 18), b = bl >> 2, l = bl & 3;
            const f32x4 v0 = __builtin_nontemporal_load((const f32x4*)(p.in[2] + e0)), v1 = __builtin_nontemporal_load((const f32x4*)(p.in[2] + e0 + 4));
            u32x4 w; w.x = pk(v0[0], v0[1]); w.y = pk(v0[2], v0[3]); w.z = pk(v1[0], v1[1]); w.w = pk(v1[2], v1[3]);
            *(u32x4*)((bf16_t*)(p.ws + O_KL) + ((size_t)(l * 2 + b) * 1280 + key) * 1024 + col) = w;
        } else if (it < NT_W + NT_MOD + NT_CK + NT_CV) {
            const int j = (it - NT_W - NT_MOD - NT_CK) * 2 + (tid >> 8);
            const int et = j & 1, kt = (j >> 1) & 3, h = (j >> 3) & 7, l = (j >> 6) & 3, b = j >> 8;
            const float* src = p.in[3] + ((size_t)(b * 4 + l) * 256) * 1024 + h * 128;
            bf16_t* dst = (bf16_t*)(p.ws + O_VTL) + ((size_t)((l * 2 + b) * 8 + h) * 128) * 1280;
            transpose_tile(src, 1024, dst, 1280, kt * 64, et * 64, 0, tile);
        } else if (it == TOTAL - 1) {
            float* RT = (float*)(p.ws + O_ROPE);
#pragma unroll
            for (int i = 0; i < 2; ++i) {
                const int e = tid + i * 512, pos = e >> 4, fi = e & 15;
                const float ang = (float)pos * fexp2(-(float)fi * 0.8304820237f);
                float rev = ang * 0.15915494309f; rev -= floorf(rev);
                RT[e] = __builtin_amdgcn_cosf(rev); RT[1024 + e] = __builtin_amdgcn_sinf(rev);
            }
            if (tid < 256) {
                const int l_ = tid >> 6, ln_ = tid & 63;
                const float* lp = p.in[15] + (size_t)l_ * 256;
                float e1 = lp[ln_] * lp[64 + ln_], e2 = lp[128 + ln_] * lp[192 + ln_];
#pragma unroll
                for (int o = 32; o >= 1; o >>= 1) { e1 += __shfl_xor(e1, o); e2 += __shfl_xor(e2, o); }
                if (ln_ == 0) RT[2048 + l_] = fexp(e1) - fexp(e2) + (0.8f - 0.6f * fexp(-0.3f * (float)l_));
            }
        } else {
            const int j = it - NT_W - NT_MOD - NT_CK - NT_CV;
            float* X = (float*)(p.ws + O_X);
#pragma unroll
            for (int i = 0; i < 4; ++i) {
                const size_t e = (size_t)j * 8192 + i * 2048 + tid * 4;
                const f32x4 v = (e < (size_t)RC * D) ? *(const f32x4*)(p.in[0] + e) : *(const f32x4*)(p.in[1] + (e - (size_t)RC * D));
                *(f32x4*)(X + e) = v;
            }
        }
    }
}

__device__ void phase_norm(const Params& p, int l, int which) {
    const int tid_ = otid(); const int lane = tid_ & 63, wid = tid_ >> 6;
    const float* X = (const float*)(p.ws + O_X);
    const float* MOD = (const float*)(p.ws + O_MOD);
    bf16_t* H = (bf16_t*)(p.ws + O_H);
    const int gw = blockIdx.x * 8 + wid, nw = gridDim.x * 8;
    for (int row0 = gw; row0 < R; row0 += 3 * nw) {
        f32x4 v[3][4];
#pragma unroll
        for (int j = 0; j < 3; ++j) {
            const int row = row0 + j * nw;
            if (row < R) {
#pragma unroll
                for (int i = 0; i < 4; ++i) v[j][i] = *(const f32x4*)(X + (size_t)row * D + i * 256 + lane * 4);
            }
        }
#pragma unroll
        for (int j = 0; j < 3; ++j) {
            const int row = row0 + j * nw;
            if (row < R) {
                float ss = 0.f;
#pragma unroll
                for (int i = 0; i < 4; ++i) ss += v[j][i][0] * v[j][i][0] + v[j][i][1] * v[j][i][1] + v[j][i][2] * v[j][i][2] + v[j][i][3] * v[j][i][3];
#pragma unroll
                for (int o = 32; o >= 1; o >>= 1) ss += __shfl_xor(ss, o);
                const float r = __builtin_amdgcn_rsqf(ss * (1.f / 1024.f) + EPS);
                if (which < 3) {
                    const float* g = p.in[8] + (size_t)(l * 3 + which) * D;
                    const float* md = MOD + (size_t)(l * 3 + cond_of_row(row)) * 9216 + (size_t)(3 * which) * D;
#pragma unroll
                    for (int i = 0; i < 4; ++i) {
                        const int c = i * 256 + lane * 4;
                        const f32x4 gg = *(const f32x4*)(g + c), sh = *(const f32x4*)(md + c), sc = *(const f32x4*)(md + D + c);
                        store_bf4(H + (size_t)row * D + c, (v[j][i] * r) * gg * (sc + 1.f) + sh);
                    }
                } else {
#pragma unroll
                    for (int i = 0; i < 4; ++i) {
                        const int c = i * 256 + lane * 4;
                        *(f32x4*)(p.out + (size_t)row * D + c) = (v[j][i] * r) * (*(const f32x4*)(p.in[22] + c));
                    }
                }
            }
        }
    }
}

enum { G_UP = 0, G_DOWN = 1, G_WIN = 2, G_BR = 3, G_OUT = 4 };

template <int KIND, int MI>
DI void gemm_item(const Params& p, int l, int second, int m0, int ntile, unsigned char* lds) {
    const int tid = otid(), wid = tid >> 6, lane = tid & 63, wr = wid >> 1, wc = wid & 1, fr = lane & 15, fq = lane >> 4;
    const bf16_t* W = (const bf16_t*)(p.ws + O_W) + (size_t)l * WE_LAYER;
    const float* MOD = (const float*)(p.ws + O_MOD);
    float* X = (float*)(p.ws + O_X);
    const bf16_t* H = (const bf16_t*)(p.ws + O_H);
    bf16_t* ACT = (bf16_t*)(p.ws + O_ACT);
    constexpr int WMR = MI * 16;
    const int n0 = ntile * 128;
    {
        f32x4 acc[MI][4];
        if (KIND == G_UP) {
            gemm_tile<MI>(H, D, W + (second ? WE_13B : WE_13A), D, D, m0, n0, acc, lds);
#pragma unroll
            for (int m = 0; m < MI; ++m) {
                const int row = m0 + wr * WMR + m * 16 + fr;
#pragma unroll
                for (int nn = 0; nn < 2; ++nn) {
                    f32x4 o;
#pragma unroll
                    for (int j = 0; j < 4; ++j) o[j] = siluf_(acc[m][nn][j]) * acc[m][nn + 2][j];
                    store_bf4(ACT + (size_t)row * DFF + ntile * 64 + wc * 32 + nn * 16 + fq * 4, o);
                }
            }
        } else if (KIND == G_DOWN || KIND == G_OUT) {
            if (KIND == G_DOWN) gemm_tile<MI>(ACT, DFF, W + (second ? WE_2B : WE_2A), DFF, DFF, m0, n0, acc, lds);
            else gemm_tile<MI>((const bf16_t*)(p.ws + O_MG), D, W + WE_O, D, D, m0, n0, acc, lds);
            const int slot = (KIND == G_OUT) ? 5 : (second ? 8 : 2);
            const float scl = (KIND == G_OUT) ? 1.f : 0.5f;
#pragma unroll
            for (int m = 0; m < MI; ++m) {
                const int row = m0 + wr * WMR + m * 16 + fr;
                const float* gt = MOD + (size_t)(l * 3 + cond_of_row(row)) * 9216 + (size_t)slot * D;
#pragma unroll
                for (int n = 0; n < 4; ++n) {
                    const int col = n0 + wc * 64 + n * 16 + fq * 4;
                    const f32x4 g = *(const f32x4*)(gt + col) * scl;
                    f32x4* xp = (f32x4*)(X + (size_t)row * D + col);
                    *xp = *xp + g * acc[m][n];
                }
            }
        } else if (KIND == G_BR) {
            const bf16_t* SG = (const bf16_t*)(p.ws + O_SG);
            gemm_tile<MI>((const bf16_t*)(p.ws + O_ABR), D, W + WE_A, D, D, m0, n0, acc, lds);
            float* MG1 = (float*)(p.ws + O_MG1);
#pragma unroll
            for (int m = 0; m < MI; ++m) {
                const int row = m0 + wr * WMR + m * 16 + fr;
#pragma unroll
                for (int n = 0; n < 4; ++n) {
                    const int col = n0 + wc * 64 + n * 16 + fq * 4;
                    const u32x2 gv = *(const u32x2*)(SG + (size_t)row * 2048 + col);
                    f32x4 g; g[0] = __uint_as_float(gv.x << 16); g[1] = __uint_as_float(gv.x & 0xffff0000u); g[2] = __uint_as_float(gv.y << 16); g[3] = __uint_as_float(gv.y & 0xffff0000u);
                    *(f32x4*)(MG1 + (size_t)row * D + col) = g * acc[m][n];
                }
            }
            gemm_tile<MI>((const bf16_t*)(p.ws + O_BBR), D, W + WE_B, D, D, m0, n0, acc, lds);
            bf16_t* MG = (bf16_t*)(p.ws + O_MG);
#pragma unroll
            for (int m = 0; m < MI; ++m) {
                const int row = m0 + wr * WMR + m * 16 + fr;
#pragma unroll
                for (int n = 0; n < 4; ++n) {
                    const int col = n0 + wc * 64 + n * 16 + fq * 4;
                    const u32x2 gv = *(const u32x2*)(SG + (size_t)row * 2048 + 1024 + col);
                    f32x4 g; g[0] = __uint_as_float(gv.x << 16); g[1] = __uint_as_float(gv.x & 0xffff0000u); g[2] = __uint_as_float(gv.y << 16); g[3] = __uint_as_float(gv.y & 0xffff0000u);
                    const f32x4 m1 = *(const f32x4*)(MG1 + (size_t)row * D + col);
                    store_bf4(MG + (size_t)row * D + col, m1 + g * acc[m][n]);
                }
            }
        } else {
            gemm_tile<MI>(H, D, W + WE_IN, D, D, m0, n0, acc, lds);
            const bool ctx = m0 < RC;
            const int b = ctx ? (m0 >> 8) : ((m0 - RC) >> 10);
            const int pos0 = (ctx ? (m0 & 255) : ((m0 - RC) & 1023)) + wr * WMR;
            if (n0 < 1024) {
                bf16_t* U = (bf16_t*)(p.ws + O_U);
#pragma unroll
                for (int m = 0; m < MI; ++m)
#pragma unroll
                    for (int n = 0; n < 4; ++n) {
                        f32x4 o;
#pragma unroll
                        for (int j = 0; j < 4; ++j) o[j] = geluf_(acc[m][n][j]);
                        store_bf4(U + (size_t)(m0 + wr * WMR + m * 16 + fr) * D + n0 + wc * 64 + n * 16 + fq * 4, o);
                    }
            } else if (n0 < 2048) {
                bf16_t* VT = (bf16_t*)(p.ws + O_VT);
                float* VSS = (float*)(p.ws + O_VSS);
#pragma unroll
                for (int m = 0; m < MI; ++m) {
                    const int row = m0 + wr * WMR + m * 16 + fr;
                    float ss = 0.f;
#pragma unroll
                    for (int n = 0; n < 4; ++n)
#pragma unroll
                        for (int j = 0; j < 4; ++j) {
                            const float gq = bfround(geluf_(acc[m][n][j]));
                            ss += gq * gq;
                            const int ch = n0 - 1024 + wc * 64 + n * 16 + fq * 4 + j;
                            VT[(size_t)ch * R + row] = (bf16_t)(__float_as_uint(gq) >> 16);
                        }
                    ss += __shfl_xor(ss, 16); ss += __shfl_xor(ss, 32);
                    if (fq == 0) VSS[(size_t)row * 16 + ((n0 - 1024) >> 7) * 2 + wc] = ss;
                }
            } else if (n0 < 4096) {
                const bool isq = n0 < 3072;
                const int cb = (isq ? n0 - 2048 : n0 - 3072) + wc * 64;
                if (!isq && ctx) {
                    float* ok = p.out + (size_t)R * D + ((size_t)(b * 4 + l) * 256) * 1024;
#pragma unroll
                    for (int m = 0; m < MI; ++m) {
#pragma unroll
                        for (int n = 0; n < 4; ++n) __builtin_nontemporal_store(acc[m][n], (f32x4*)(ok + (size_t)(pos0 + m * 16 + fr) * 1024 + cb + n * 16 + fq * 4));
                        __builtin_amdgcn_sched_barrier(0);
                    }
                    __builtin_amdgcn_sched_barrier(0);
                }
                if (!ctx) {
                    const float* RC_ = (const float*)(p.ws + O_ROPE);
                    const f32x4 cr = *(const f32x4*)(RC_ + (pos0 >> 6) * 16 + fq * 4), sr = *(const f32x4*)(RC_ + 1024 + (pos0 >> 6) * 16 + fq * 4);
#pragma unroll
                    for (int m = 0; m < MI; ++m) {
                        const int gc = (pos0 & 63) + m * 16 + fr;
                        const f32x4 cc = *(const f32x4*)(RC_ + gc * 16 + fq * 4), sc = *(const f32x4*)(RC_ + 1024 + gc * 16 + fq * 4);
                        const f32x4 x1 = acc[m][0], x2 = acc[m][1], y1 = acc[m][2], y2 = acc[m][3];
                        acc[m][0] = x1 * cr - x2 * sr; acc[m][1] = x2 * cr + x1 * sr;
                        acc[m][2] = y1 * cc - y2 * sc; acc[m][3] = y2 * cc + y1 * sc;
                    }
                }
                bf16_t* dst; size_t rowbase;
                if (isq) { dst = (bf16_t*)(p.ws + O_Q); rowbase = (size_t)(m0 + wr * WMR); }
                else if (ctx) { dst = (bf16_t*)(p.ws + O_KC); rowbase = (size_t)(m0 + wr * WMR); }
                else { dst = (bf16_t*)(p.ws + O_KL); rowbase = (size_t)(l * 2 + b) * 1280 + 256 + pos0; }
                const float qs = isq ? 0.18033688011f : 1.f;
#pragma unroll
                for (int m = 0; m < MI; ++m) {
#pragma unroll
                    for (int n = 0; n < 4; ++n) store_bf4(dst + (rowbase + m * 16 + fr) * 1024 + cb + n * 16 + fq * 4, acc[m][n] * qs);
                    __builtin_amdgcn_sched_barrier(0);
                }
            } else if (n0 < 5120) {
                const int h = (n0 - 4096) >> 7;
                if (ctx) {
                    float* ov = p.out + (size_t)R * D + (size_t)16 * 4 * 256 * 1024 + ((size_t)(b * 4 + l) * 256) * 1024;
#pragma unroll
                    for (int m = 0; m < MI; ++m)
#pragma unroll
                        for (int n = 0; n < 4; ++n) __builtin_nontemporal_store(acc[m][n], (f32x4*)(ov + (size_t)(pos0 + m * 16 + fr) * 1024 + (n0 - 4096) + wc * 64 + n * 16 + fq * 4));
                }
                bf16_t* vt; int ldv, koff;
                if (ctx) { vt = (bf16_t*)(p.ws + O_VTC) + ((size_t)(b * 8 + h) * 128) * 256; ldv = 256; koff = pos0; }
                else { vt = (bf16_t*)(p.ws + O_VTL) + ((size_t)((l * 2 + b) * 8 + h) * 128) * 1280; ldv = 1280; koff = 256 + pos0; }
#pragma unroll
                for (int m = 0; m < MI; ++m)
#pragma unroll
                    for (int n = 0; n < 4; ++n)
#pragma unroll
                        for (int j = 0; j < 4; ++j) {
                            const int e = wc * 64 + n * 16 + fq * 4 + j;
                            vt[(size_t)e * ldv + koff + m * 16 + fr] = (bf16_t)(pk(acc[m][n][j], 0.f) & 0xffffu);
                            if (j == 3) __builtin_amdgcn_sched_barrier(0);
                        }
            } else {
                bf16_t* SG = (bf16_t*)(p.ws + O_SG);
#pragma unroll
                for (int m = 0; m < MI; ++m)
#pragma unroll
                    for (int n = 0; n < 4; ++n) {
                        f32x4 o;
#pragma unroll
                        for (int j = 0; j < 4; ++j) o[j] = sigmoidf_(acc[m][n][j]);
                        store_bf4(SG + (size_t)(m0 + wr * WMR + m * 16 + fr) * 2048 + (n0 - 5120) + wc * 64 + n * 16 + fq * 4, o);
                    }
            }
        }
    }
}

template <int KIND>
__device__ void phase_gemm(const Params& p, int l, int second, unsigned char* lds) {
    const int G = (int)gridDim.x, bid = (int)blockIdx.x;
    if (KIND == G_UP || KIND == G_WIN) {
        const int NTN = (KIND == G_UP) ? 44 : 56, ntiles = 24 * NTN;
        if ((G & 7) == 0) {
            const int x = bid & 7, lb = bid >> 3, nb = G >> 3, mx = x & 3, nx = x >> 2, npx = NTN >> 1, nloc = 6 * npx;
            const int nfull = (nloc / nb) * nb, nrem = nloc - nfull;
            for (int j = lb; j < nfull; j += nb) gemm_item<KIND, 4>(p, l, second, (mx * 6 + j % 6) * 256, nx * npx + j / 6, lds);
            for (int q = lb; q < nrem * 4; q += nb) { const int j = nfull + (q >> 2); gemm_item<KIND, 1>(p, l, second, (mx * 6 + j % 6) * 256 + (q & 3) * 64, nx * npx + j / 6, lds); }
        } else {
            const int nfull = (ntiles / G) * G, nrem = ntiles - nfull;
            for (int t = bid; t < nfull; t += G) gemm_item<KIND, 4>(p, l, second, (t % 24) * 256, t / 24, lds);
            for (int j = bid; j < nrem * 4; j += G) { const int t = nfull + (j >> 2); gemm_item<KIND, 1>(p, l, second, (t % 24) * 256 + (j & 3) * 64, t / 24, lds); }
        }
    } else {
        for (int t = bid; t < 32 * 8; t += G) gemm_item<KIND, 3>(p, l, second, (t % 32) * 192, t / 32, lds);
    }
}

__device__ void spatial_item(const Params& p, int l, int item, unsigned char* lds) {
    const int tid = otid(), wid = tid >> 6, lane = tid & 63, wr = wid >> 2, wc = wid & 3, fr = lane & 15, fq = lane >> 4;
    const int g = item & 3, ck = item >> 2;
    const int m0 = ck * 128, c0 = g * 256;
    const bf16_t* VT = (const bf16_t*)(p.ws + O_VT);
    const float* VSS = (const float*)(p.ws + O_VSS);
    float* rstd = (float*)(lds + LDS_X);
    __syncthreads();
    if (tid < 128) {
        const f32x4* q = (const f32x4*)(VSS + (size_t)(m0 + tid) * 16);
        const f32x4 a = q[0] + q[1] + q[2] + q[3];
        rstd[tid] = __builtin_amdgcn_rsqf((a[0] + a[1] + a[2] + a[3]) * (1.f / 1024.f) + EPS);
    }
    stage_half<4>(lds + 32768, VT + (size_t)c0 * R + m0, R, tid);
    stage_half<4>(lds + 65536, VT + (size_t)c0 * R + m0 + 64, R, tid);
    __syncthreads();
    const float* ws = p.in[13] + (size_t)(l * 4 + g) * 128 * 128;
#pragma unroll
    for (int t = 0; t < 2; ++t)
#pragma unroll
        for (int i = 0; i < 2; ++i) {
            const int b = tid * 16 + i * 8192; int r, c; stage_rc(b, r, c);
            const f32x4 v0 = *(const f32x4*)(ws + r * 128 + t * 64 + c), v1 = *(const f32x4*)(ws + r * 128 + t * 64 + c + 4);
            const float* rs = rstd + t * 64 + c;
            u32x4 w; w.x = pk(v0[0] * rs[0], v0[1] * rs[1]); w.y = pk(v0[2] * rs[2], v0[3] * rs[3]); w.z = pk(v1[0] * rs[4], v1[1] * rs[5]); w.w = pk(v1[2] * rs[6], v1[3] * rs[7]);
            *(u32x4*)(lds + t * 16384 + b) = w;
        }
    WAIT_VM0();
    __syncthreads();
    f32x4 acc[4][4];
#pragma unroll
    for (int m = 0; m < 4; ++m)
#pragma unroll
        for (int n = 0; n < 4; ++n) acc[m][n] = (f32x4){0.f, 0.f, 0.f, 0.f};
    { const unsigned la = lds_addr(lds) + lds_byte(wr * 64 + fr, fq * 8), lb = lds_addr(lds) + 32768 + lds_byte(wc * 64 + fr, fq * 8);
      compute_ktile<4>(la, lb, acc);
      compute_ktile<4>(la + 16384, lb + 32768, acc); }
    const bf16_t* U = (const bf16_t*)(p.ws + O_U);
    bf16_t* ABR = (bf16_t*)(p.ws + O_ABR);
    const float* gain = p.in[12] + (size_t)l * D;
    const float* bs = p.in[14] + (size_t)(l * 4 + g) * 128;
#pragma unroll
    for (int m = 0; m < 4; ++m) {
        const int pr = wr * 64 + m * 16 + fr;
        const float bias = bs[pr];
#pragma unroll
        for (int n = 0; n < 4; ++n) {
            const int col = c0 + wc * 64 + n * 16 + fq * 4;
            const f32x4 gn = *(const f32x4*)(gain + col);
            const u32x2 uv = *(const u32x2*)(U + (size_t)(m0 + pr) * D + col);
            f32x4 u; u[0] = __uint_as_float(uv.x << 16); u[1] = __uint_as_float(uv.x & 0xffff0000u); u[2] = __uint_as_float(uv.y << 16); u[3] = __uint_as_float(uv.y & 0xffff0000u);
            store_bf4(ABR + (size_t)(m0 + pr) * D + col, u * (gn * acc[m][n] + bias));
        }
    }
}

__device__ void attn_item(const Params& p, int l, bool ctx, int b, int h, int qt, unsigned char* lds) {
    const int tid = otid(), wid = tid >> 6, lane = tid & 63, fr = lane & 15, fq = lane >> 4;
    const int qrow0 = (ctx ? b * 256 : RC + b * 1024) + qt * 128 + wid * 16;
    const bf16_t* Kb = ctx ? (const bf16_t*)(p.ws + O_KC) + (size_t)(b * 256) * 1024 + h * 128
                           : (const bf16_t*)(p.ws + O_KL) + ((size_t)(l * 2 + b) * 1280) * 1024 + h * 128;
    const int ldv = ctx ? 256 : 1280;
    const bf16_t* Vb = ctx ? (const bf16_t*)(p.ws + O_VTC) + ((size_t)(b * 8 + h) * 128) * 256
                           : (const bf16_t*)(p.ws + O_VTL) + ((size_t)((l * 2 + b) * 8 + h) * 128) * 1280;
    const int nt = ctx ? 4 : 20;
    const float lam_init = 0.8f - 0.6f * fexp(-0.3f * (float)l);
    const float lam = ((const float*)(p.ws + O_ROPE))[2048 + l];
    const bf16_t* Q = (const bf16_t*)(p.ws + O_Q) + (size_t)(qrow0 + fr) * 1024 + h * 128;
    bf16x8 qf[2][2];
#pragma unroll
    for (int i2 = 0; i2 < 2; ++i2)
#pragma unroll
        for (int ks = 0; ks < 2; ++ks) qf[i2][ks] = *(const bf16x8*)(Q + i2 * 64 + ks * 32 + fq * 8);
    f32x4 O1[8], O2[8];
#pragma unroll
    for (int e = 0; e < 8; ++e) { O1[e] = (f32x4){0.f, 0.f, 0.f, 0.f}; O2[e] = O1[e]; }
    float mrun[2] = {-1e30f, -1e30f}, lsum[2] = {0.f, 0.f};

    __syncthreads();
#define STAGE_KV(s, t)                                                                                             \
    do {                                                                                                           \
        _Pragma("unroll") for (int i = 0; i < 2; ++i) {                                                            \
            const int P = tid + i * 512;                                                                           \
            const int key = P >> 4, c = (P & 15) ^ (key & 15);                                                     \
            glds16(Kb + (size_t)((t) * 64 + key) * 1024 + c * 8, lds + (s) * 32768 + P * 16);                      \
        }                                                                                                          \
        _Pragma("unroll") for (int i = 0; i < 2; ++i) {                                                            \
            const int P = tid + i * 512;                                                                           \
            const int e = P >> 3, c = (P & 7) ^ ((e >> 1) & 7);                                                    \
            glds16(Vb + (size_t)e * ldv + (t) * 64 + c * 8, lds + (s) * 32768 + 16384 + P * 16);                   \
        }                                                                                                          \
    } while (0)
    unsigned aK[2][2], aV[2][2];
    {
        const unsigned lb0 = lds_addr(lds), sw = (unsigned)(fr >> 1) & 7u;
#pragma unroll
        for (int i2 = 0; i2 < 2; ++i2)
#pragma unroll
            for (int ks = 0; ks < 2; ++ks) aK[i2][ks] = lb0 + fr * 256 + ((((unsigned)(i2 * 8 + ks * 4 + fq)) ^ (unsigned)fr) << 4);
#pragma unroll
        for (int kk = 0; kk < 2; ++kk)
#pragma unroll
            for (int h2 = 0; h2 < 2; ++h2) aV[kk][h2] = lb0 + 16384 + fr * 128 + ((((unsigned)(kk * 4 + (fq >> 1) + 2 * h2)) ^ sw) << 4) + (fq & 1) * 8;
    }
#define LDS_RD64(dst, base, off) asm volatile("ds_read_b64 %0, %1 offset:" #off : "=v"(dst) : "v"(base) : "memory")
    STAGE_KV(0, 0); STAGE_KV(1, 1);
    int cur = 0, nxt = 2;
    for (int t = 0; t < nt; ++t) {
        if (t + 1 < nt) asm volatile("s_waitcnt vmcnt(4)" ::: "memory"); else asm volatile("s_waitcnt vmcnt(0)" ::: "memory");
        __builtin_amdgcn_sched_barrier(0);
        asm volatile("" ::: "memory");
        __builtin_amdgcn_s_barrier();
        asm volatile("" ::: "memory");
        __builtin_amdgcn_sched_barrier(0);
        if (t + 2 < nt) STAGE_KV(nxt, t + 2);
        const unsigned off = (unsigned)cur * 32768u;
        cur = (cur == 2) ? 0 : cur + 1; nxt = (nxt == 2) ? 0 : nxt + 1;
        f32x4 s[2][4];
        {
            bf16x8 kf[2][4][2];
            const unsigned k00 = aK[0][0] + off, k01 = aK[0][1] + off, k10 = aK[1][0] + off, k11 = aK[1][1] + off;
            LDS_RD(kf[0][0][0], k00, 0); LDS_RD(kf[0][0][1], k01, 0); LDS_RD(kf[0][1][0], k00, 4096); LDS_RD(kf[0][1][1], k01, 4096);
            LDS_RD(kf[0][2][0], k00, 8192); LDS_RD(kf[0][2][1], k01, 8192); LDS_RD(kf[0][3][0], k00, 12288); LDS_RD(kf[0][3][1], k01, 12288);
            LDS_RD(kf[1][0][0], k10, 0); LDS_RD(kf[1][0][1], k11, 0); LDS_RD(kf[1][1][0], k10, 4096); LDS_RD(kf[1][1][1], k11, 4096);
            LDS_RD(kf[1][2][0], k10, 8192); LDS_RD(kf[1][2][1], k11, 8192); LDS_RD(kf[1][3][0], k10, 12288); LDS_RD(kf[1][3][1], k11, 12288);
            __builtin_amdgcn_sched_barrier(0);
            asm volatile("s_waitcnt lgkmcnt(8)" ::: "memory");
            __builtin_amdgcn_sched_barrier(0);
#pragma unroll
            for (int kt = 0; kt < 4; ++kt) {
                s[0][kt] = __builtin_amdgcn_mfma_f32_16x16x32_bf16(kf[0][kt][0], qf[0][0], (f32x4){0.f, 0.f, 0.f, 0.f}, 0, 0, 0);
                s[0][kt] = __builtin_amdgcn_mfma_f32_16x16x32_bf16(kf[0][kt][1], qf[0][1], s[0][kt], 0, 0, 0);
            }
            __builtin_amdgcn_sched_barrier(0);
            asm volatile("s_waitcnt lgkmcnt(0)" ::: "memory");
            __builtin_amdgcn_sched_barrier(0);
#pragma unroll
            for (int kt = 0; kt < 4; ++kt) {
                s[1][kt] = __builtin_amdgcn_mfma_f32_16x16x32_bf16(kf[1][kt][0], qf[1][0], (f32x4){0.f, 0.f, 0.f, 0.f}, 0, 0, 0);
                s[1][kt] = __builtin_amdgcn_mfma_f32_16x16x32_bf16(kf[1][kt][1], qf[1][1], s[1][kt], 0, 0, 0);
            }
            __builtin_amdgcn_sched_barrier(0);
        }
        bf16x8 pf[2][2];
#pragma unroll
        for (int i2 = 0; i2 < 2; ++i2) {
            float mx = -1e30f;
#pragma unroll
            for (int kt = 0; kt < 4; ++kt)
#pragma unroll
                for (int j = 0; j < 4; ++j) mx = fmaxf(mx, s[i2][kt][j]);
            mx = fmaxf(mx, __shfl_xor(mx, 16)); mx = fmaxf(mx, __shfl_xor(mx, 32));
            if (__builtin_amdgcn_ballot_w64(mx > mrun[i2] + 8.f) != 0) {
                const float mn = fmaxf(mrun[i2], mx);
                const float alpha = fexp2(mrun[i2] - mn);
                mrun[i2] = mn;
                lsum[i2] *= alpha;
                if (i2 == 0) {
#pragma unroll
                    for (int e = 0; e < 8; ++e) O1[e] = O1[e] * alpha;
                } else {
#pragma unroll
                    for (int e = 0; e < 8; ++e) O2[e] = O2[e] * alpha;
                }
            }
            const float mn = mrun[i2];
            float ps = 0.f;
#pragma unroll
            for (int kt = 0; kt < 4; ++kt)
#pragma unroll
                for (int j = 0; j < 4; ++j) { const float pv = fexp2(s[i2][kt][j] - mn); s[i2][kt][j] = pv; ps += pv; }
            lsum[i2] += ps;
#pragma unroll
            for (int kk = 0; kk < 2; ++kk) {
                u32x4 w;
                w.x = pk(s[i2][2 * kk][0], s[i2][2 * kk][1]); w.y = pk(s[i2][2 * kk][2], s[i2][2 * kk][3]);
                w.z = pk(s[i2][2 * kk + 1][0], s[i2][2 * kk + 1][1]); w.w = pk(s[i2][2 * kk + 1][2], s[i2][2 * kk + 1][3]);
                pf[i2][kk] = __builtin_bit_cast(bf16x8, w);
            }
        }
        {
            const unsigned v00 = aV[0][0] + off, v01 = aV[0][1] + off, v10 = aV[1][0] + off, v11 = aV[1][1] + off;
            u32x2 vl[8][2], vh[8][2];
#define RDV(et, o) do { LDS_RD64(vl[et][0], v00, o); LDS_RD64(vh[et][0], v01, o); LDS_RD64(vl[et][1], v10, o); LDS_RD64(vh[et][1], v11, o); } while (0)
#define PV_STEP(et, WAITN) do { __builtin_amdgcn_sched_barrier(0); asm volatile("s_waitcnt lgkmcnt(" #WAITN ")" ::: "memory"); __builtin_amdgcn_sched_barrier(0); \
            _Pragma("unroll") for (int kk = 0; kk < 2; ++kk) { u32x4 w; w.x = vl[et][kk].x; w.y = vl[et][kk].y; w.z = vh[et][kk].x; w.w = vh[et][kk].y; \
                const bf16x8 vf = __builtin_bit_cast(bf16x8, w); \
                O1[et] = __builtin_amdgcn_mfma_f32_16x16x32_bf16(vf, pf[0][kk], O1[et], 0, 0, 0); O2[et] = __builtin_amdgcn_mfma_f32_16x16x32_bf16(vf, pf[1][kk], O2[et], 0, 0, 0); } \
            __builtin_amdgcn_sched_barrier(0); } while (0)
            RDV(0, 0); RDV(1, 2048); RDV(2, 4096);
            PV_STEP(0, 8); RDV(3, 6144);
            PV_STEP(1, 8); RDV(4, 8192);
            PV_STEP(2, 8); RDV(5, 10240);
            PV_STEP(3, 8); RDV(6, 12288);
            PV_STEP(4, 8); RDV(7, 14336);
            PV_STEP(5, 8);
            PV_STEP(6, 4);
            PV_STEP(7, 0);
#undef PV_STEP
#undef RDV
        }
    }
#undef STAGE_KV
    float l1 = lsum[0], l2 = lsum[1];
    l1 += __shfl_xor(l1, 16); l1 += __shfl_xor(l1, 32);
    l2 += __shfl_xor(l2, 16); l2 += __shfl_xor(l2, 32);
    const float i1 = 1.f / l1, i2s = lam / l2;
    float ss = 0.f;
#pragma unroll
    for (int e = 0; e < 8; ++e) {
        O1[e] = O1[e] * i1 - O2[e] * i2s;
        ss += O1[e][0] * O1[e][0] + O1[e][1] * O1[e][1] + O1[e][2] * O1[e][2] + O1[e][3] * O1[e][3];
    }
    ss += __shfl_xor(ss, 16); ss += __shfl_xor(ss, 32);
    const float rn = __builtin_amdgcn_rsqf(ss * (1.f / 128.f) + EPS) * (1.f - lam_init);
    const float* sg = p.in[16] + (size_t)l * 128;
    bf16_t* BBR = (bf16_t*)(p.ws + O_BBR) + (size_t)(qrow0 + fr) * 1024 + h * 128;
#pragma unroll
    for (int e = 0; e < 8; ++e) {
        const f32x4 gn = *(const f32x4*)(sg + e * 16 + fq * 4);
        store_bf4(BBR + e * 16 + fq * 4, O1[e] * rn * gn);
    }
}

__device__ void phase_mix(const Params& p, int l, unsigned char* lds) {
    constexpr int NQ = 16 + 32 + 24;
    unsigned* ctr = (unsigned*)(p.ws + O_BAR + 14336) + l * 128;
    volatile int* slot = (volatile int*)(lds + LDS_X + 528);
    const int x0 = (int)(__builtin_amdgcn_s_getreg((3 << 11) | 20) & 7u);
    for (int dq = 0; dq < 8; ++dq) {
        const int q = (x0 + dq) & 7;
        for (;;) {
            __syncthreads();
            if (threadIdx.x == 0) *slot = (int)__hip_atomic_fetch_add(ctr + q * 16, 1u, __ATOMIC_RELAXED, __HIP_MEMORY_SCOPE_AGENT);
            __syncthreads();
            const int k = *slot;
            if (k >= NQ) break;
            if (k < 16) attn_item(p, l, false, k >> 3, q, k & 7, lds);
            else if (k < 48) attn_item(p, l, true, (k - 16) >> 1, q, (k - 16) & 1, lds);
            else spatial_item(p, l, q * 24 + (k - 48), lds);
        }
    }
}

#define XB_TMO      128
#define XB_XCNT(j)  (256  + 64 * (j))
#define XB_XSUB(j)  (1280 + 64 * (j))
#define XB_XGEN(j)  (2304 + 64 * (j))
#define XB_TOP      3328
#define XB_TOPGEN   3392
#define XCD_BAR_WORDS 3456
#define XB_SPIN_CAP (1u << 18)
#define LAS __attribute__((address_space(3)))

__device__ __forceinline__ unsigned xb_ld(unsigned* p)              { return __hip_atomic_load(p, __ATOMIC_RELAXED, __HIP_MEMORY_SCOPE_AGENT); }
__device__ __forceinline__ unsigned xb_add(unsigned* p, unsigned v) { return __hip_atomic_fetch_add(p, v, __ATOMIC_RELAXED, __HIP_MEMORY_SCOPE_AGENT); }
__device__ __forceinline__ unsigned xb_xcc_id() { return (unsigned)__builtin_amdgcn_s_getreg((3 << 11) | 20) & 0xFu; }
#define XB_SPIN(cond, bar) do { unsigned _sp = 0; while (cond) { __builtin_amdgcn_s_sleep(1); \
    if ((++_sp & 255u) == 0u) { if (xb_ld(&(bar)[XB_TMO])) break; if (_sp > XB_SPIN_CAP) { atomicAdd(&(bar)[XB_TMO], 1u); break; } } } } while (0)

struct XcdBarrier {
    unsigned* bar; unsigned x;
    volatile LAS unsigned* st;
};

__device__ __forceinline__ XcdBarrier xcd_barrier_post(unsigned* bar, volatile LAS unsigned* st) {
    XcdBarrier b; b.bar = bar; b.x = xb_xcc_id(); b.st = st;
    if (threadIdx.x == 0) (void)xb_add(&bar[XB_XCNT(b.x)], 1u);
    return b;
}
__device__ __forceinline__ void xcd_barrier_complete(unsigned* bar, unsigned x, unsigned& nloc, unsigned& nx) {
    const unsigned G = gridDim.x * gridDim.y * gridDim.z;
    unsigned sum, cnt, mine, sp = 0u;
    for (;;) {
        sum = 0u; cnt = 0u; mine = 0u;
#pragma unroll
        for (unsigned j = 0; j < 16; ++j) { const unsigned c = xb_ld(&bar[XB_XCNT(j)]); sum += c; cnt += (c > 0u) ? 1u : 0u; mine = (j == x) ? c : mine; }
        if (sum == G) break;
        __builtin_amdgcn_s_sleep(1);
        if ((++sp & 255u) == 0u) { if (xb_ld(&bar[XB_TMO])) break; if (sp > XB_SPIN_CAP) { atomicAdd(&bar[XB_TMO], 1u); break; } }
    }
    nloc = mine > 0u ? mine : 1u; nx = cnt > 0u ? cnt : 1u;
}

__device__ __forceinline__ void xcd_barrier(const XcdBarrier& b) {
    asm volatile("s_waitcnt vmcnt(0)" ::: "memory");
    __syncthreads();
    if (threadIdx.x == 0) {
        unsigned* bar = b.bar;
        __builtin_amdgcn_s_waitcnt(0);
        unsigned nloc = b.st[0], nx = b.st[1];
        if (nloc == 0u) { xcd_barrier_complete(bar, b.x, nloc, nx); b.st[0] = nloc; b.st[1] = nx; }
        const unsigned old = xb_add(&bar[XB_XSUB(b.x)], 1u);
        const unsigned gen = old / nloc;
        if (old + 1u == (gen + 1u) * nloc) {
            __builtin_amdgcn_fence(__ATOMIC_RELEASE, "agent");
            asm volatile("s_waitcnt vmcnt(0)" ::: "memory");
            const unsigned og = xb_add(&bar[XB_TOP], 1u);
            const unsigned tg = og / nx;
            if (og + 1u == (tg + 1u) * nx) xb_add(&bar[XB_TOPGEN], 1u);
            else XB_SPIN(xb_ld(&bar[XB_TOPGEN]) == tg, bar);
            __builtin_amdgcn_fence(__ATOMIC_ACQUIRE, "agent");
            xb_add(&bar[XB_XGEN(b.x)], 1u);
            asm volatile("s_waitcnt vmcnt(0)" ::: "memory");
        } else {
            XB_SPIN(xb_ld(&bar[XB_XGEN(b.x)]) == gen, bar);
            __builtin_amdgcn_fence(__ATOMIC_ACQUIRE, "agent");
            asm volatile("s_waitcnt vmcnt(0)" ::: "memory");
        }
    }
    __syncthreads();
}


constexpr int NPHASE = 46;
__device__ void run_phase(const Params& p, int ph, unsigned char* lds) {
    if (ph == 0) { phase_prologue(p, lds); return; }
    if (ph == NPHASE - 1) { phase_norm(p, 0, 3); return; }
    const int l = (ph - 1) / 11, s = (ph - 1) % 11;
    switch (s) {
        case 0: phase_norm(p, l, 0); break;
        case 1: phase_gemm<G_UP>(p, l, 0, lds); break;
        case 2: phase_gemm<G_DOWN>(p, l, 0, lds); break;
        case 3: phase_norm(p, l, 1); break;
        case 4: phase_gemm<G_WIN>(p, l, 0, lds); break;
        case 5: phase_mix(p, l, lds); break;
        case 6: phase_gemm<G_BR>(p, l, 0, lds); break;
        case 7: phase_gemm<G_OUT>(p, l, 0, lds); break;
        case 8: phase_norm(p, l, 2); break;
        case 9: phase_gemm<G_UP>(p, l, 1, lds); break;
        default: phase_gemm<G_DOWN>(p, l, 1, lds); break;
    }
}

__global__ void __launch_bounds__(NTHR, 2) fwd_kernel(Params p) {
    extern __shared__ __attribute__((aligned(16))) unsigned char lds[];
#if COOP
    cg::grid_group grid = cg::this_grid();
    volatile LAS unsigned* st = (volatile LAS unsigned*)(lds + LDS_X + 512);
    if (threadIdx.x == 0) { st[0] = 0u; st[1] = 0u; st[2] = 0u; st[3] = 0u; }
    __syncthreads();
    XcdBarrier xb = xcd_barrier_post((unsigned*)(p.ws + O_BAR), st);
    for (int ph = p.ph_lo; ph < p.ph_hi; ++ph) {
#ifdef PROBE_DUP
        { const int s_ = (ph == 0) ? 16 : (ph == NPHASE - 1 ? 17 : (ph - 1) % 11);
          const int nrep = ((PROBE_DUP >> s_) & 1) ? 2 : 1;
          for (int rep = 0; rep < nrep; ++rep) { if (rep) xcd_barrier(xb); run_phase(p, ph, lds); }
          if ((PROBE_DUP >> 20) & 1) { xcd_barrier(xb); } }
#else
        run_phase(p, ph, lds);
#endif
        if (ph + 1 < p.ph_hi) { if (p.ph_lo < 0) grid.sync(); else xcd_barrier(xb); }
    }
#else
    for (int ph = p.ph_lo; ph < p.ph_hi; ++ph) run_phase(p, ph, lds);
#endif
}

extern "C" void kernel_launch(void* const* d_in, const int* in_sizes, int n_in, void* d_out, int out_size, void* d_ws, size_t ws_size, hipStream_t stream) {
    static int grid_blocks = 0;
    if (!grid_blocks) {
        int dev = 0, cus = 0, per_cu = 0;
        hipGetDevice(&dev);
        hipDeviceGetAttribute(&cus, hipDeviceAttributeMultiprocessorCount, dev);
        hipFuncSetAttribute((const void*)fwd_kernel, hipFuncAttributeMaxDynamicSharedMemorySize, LDS_BYTES);
        hipOccupancyMaxActiveBlocksPerMultiprocessor(&per_cu, (const void*)fwd_kernel, NTHR, LDS_BYTES);
        if (per_cu < 1) per_cu = 1;
        if (per_cu > 1) per_cu = 1;
        grid_blocks = cus * per_cu;
        if (n_in != 23 || ws_size < WS_END) fprintf(stderr, "kernel_launch: unexpected n_in %d or ws_size %zu (need %zu)\n", n_in, ws_size, (size_t)WS_END);
    }
    Params p{};
    for (int i = 0; i < 23; ++i) p.in[i] = (const float*)d_in[i];
    p.out = (float*)d_out; p.ws = (unsigned char*)d_ws;
#if COOP
    p.ph_lo = 0; p.ph_hi = NPHASE;
    (void)hipMemsetAsync((unsigned char*)d_ws + O_BAR, 0, 16384, stream);
    void* args[] = {&p};
    hipError_t e = hipLaunchCooperativeKernel((const void*)fwd_kernel, dim3(grid_blocks), dim3(NTHR), args, LDS_BYTES, stream);
    if (e != hipSuccess) fprintf(stderr, "cooperative launch failed: %s (grid %d)\n", hipGetErrorString(e), grid_blocks);
#else
    for (int ph = 0; ph < NPHASE; ++ph) {
        p.ph_lo = ph; p.ph_hi = ph + 1;
        hipLaunchKernelGGL(fwd_kernel, dim3(grid_blocks), dim3(NTHR), LDS_BYTES, stream, p);
    }
#endif
}
```

```cpp
#include <hip/hip_runtime.h>
#include <hip/hip_cooperative_groups.h>
#include <cstdio>
#include <cstdint>
namespace cg = cooperative_groups;

#ifndef COOP
#define COOP 1
#endif

typedef unsigned short bf16_t;
typedef short bf16x8 __attribute__((ext_vector_type(8)));
typedef short s16x4 __attribute__((ext_vector_type(4)));
typedef float f32x4 __attribute__((ext_vector_type(4)));
typedef float f32x2 __attribute__((ext_vector_type(2)));
typedef __bf16 bf16x2_t __attribute__((ext_vector_type(2)));
typedef unsigned u32x2 __attribute__((ext_vector_type(2)));
typedef unsigned u32x4 __attribute__((ext_vector_type(4)));

#define DI __device__ __forceinline__

constexpr int R = 6144;
constexpr int RC = 4096;
constexpr int D = 1024;
constexpr int DFF = 2816;
constexpr int INW = 7168;
constexpr int NTHR = 512;
constexpr int LDS_X = 147456;
constexpr int LDS_BYTES = LDS_X + 1024;
constexpr float EPS = 1e-6f;

constexpr size_t al(size_t x) { return (x + 255) & ~(size_t)255; }
constexpr size_t O_X = 0;
constexpr size_t O_H = al(O_X + (size_t)R * D * 4);
constexpr size_t O_ACT = al(O_H + (size_t)R * D * 2);
constexpr size_t O_U = al(O_ACT + (size_t)R * DFF * 2);
constexpr size_t O_VT = al(O_U + (size_t)R * D * 2);
constexpr size_t O_VSS = al(O_VT + (size_t)R * D * 2);
constexpr size_t O_Q = al(O_VSS + (size_t)R * 16 * 4);
constexpr size_t O_KC = al(O_Q + (size_t)R * D * 2);
constexpr size_t O_KL = al(O_KC + (size_t)RC * D * 2);
constexpr size_t O_VTC = al(O_KL + (size_t)8 * 1280 * D * 2);
constexpr size_t O_VTL = al(O_VTC + (size_t)16 * 8 * 128 * 256 * 2);
constexpr size_t O_SG = al(O_VTL + (size_t)8 * 8 * 128 * 1280 * 2);
constexpr size_t O_ABR = al(O_SG + (size_t)R * 2048 * 2);
constexpr size_t O_BBR = al(O_ABR + (size_t)R * D * 2);
constexpr size_t O_MG = al(O_BBR + (size_t)R * D * 2);
constexpr size_t O_MG1 = al(O_MG + (size_t)R * D * 2);
constexpr size_t O_MOD = al(O_MG1 + (size_t)R * D * 4);
constexpr size_t O_ROPE = al(O_MOD + (size_t)4 * 3 * 9216 * 4);
constexpr size_t O_W = al(O_ROPE + 8192);
constexpr size_t WE_13A = 0;
constexpr size_t WE_2A = WE_13A + (size_t)5632 * 1024;
constexpr size_t WE_IN = WE_2A + (size_t)1024 * 2816;
constexpr size_t WE_A = WE_IN + (size_t)7168 * 1024;
constexpr size_t WE_B = WE_A + (size_t)1024 * 1024;
constexpr size_t WE_O = WE_B + (size_t)1024 * 1024;
constexpr size_t WE_13B = WE_O + (size_t)1024 * 1024;
constexpr size_t WE_2B = WE_13B + (size_t)5632 * 1024;
constexpr size_t WE_LAYER = WE_2B + (size_t)1024 * 2816;
constexpr size_t O_BAR = al(O_W + WE_LAYER * 4 * 2);
constexpr size_t WS_END = O_BAR + 16384;

struct Params {
    const float* in[23];
    float* out;
    unsigned char* ws;
    int ph_lo, ph_hi;
};

DI unsigned pk(float a, float b) { f32x2 v = {a, b}; bf16x2_t r = __builtin_convertvector(v, bf16x2_t); return __builtin_bit_cast(unsigned, r); }
DI float bf2f(bf16_t v) { return __uint_as_float(((unsigned)v) << 16); }
DI float bfround(float a) { unsigned u = pk(a, 0.f); return __uint_as_float(u << 16); }
DI float fexp2(float x) { return __builtin_amdgcn_exp2f(x); }
DI float fexp(float x) { return __builtin_amdgcn_exp2f(x * 1.44269504089f); }
DI float frcp(float x) { return __builtin_amdgcn_rcpf(x); }
DI float sigmoidf_(float x) { return frcp(1.f + fexp(-x)); }
DI float siluf_(float x) { return x * sigmoidf_(x); }
DI float geluf_(float x) { float u = 0.7978845608f * (x + 0.044715f * x * x * x); return x * frcp(1.f + fexp(-2.f * u)); }
DI int otid() { int t = threadIdx.x; asm volatile("" : "+v"(t)); return t; }
DI int cond_of_row(int row) { return row < RC ? 0 : 1 + ((row - RC) >> 10); }

DI int lds_byte(int r, int c) { const int st = (r >> 4) * 2 + (c >> 5), rr = r & 15, cc = c & 31, ob = rr * 64 + cc * 2; return st * 1024 + (ob ^ (((ob >> 9) & 1) << 5)); }
DI void stage_rc(int b, int& Rr, int& Cc) { const int st = b / 1024, sb = b % 1024, swz = sb ^ (((sb >> 9) & 1) << 5); Rr = (st >> 1) * 16 + swz / 64; Cc = (st & 1) * 32 + (swz % 64) / 2; }

DI void glds16(const void* g, void* l) { __builtin_amdgcn_global_load_lds((const unsigned*)g, (unsigned*)l, 16, 0, 0); }
#define WAIT_VM0() asm volatile("s_waitcnt vmcnt(0)" ::: "memory")

template <int NI = 4>
DI void stage_half(unsigned char* buf, const bf16_t* src, int ld, int tid) {
#pragma unroll
    for (int i = 0; i < NI; ++i) {
        const int b = tid * 16 + i * 8192; int r, c; stage_rc(b, r, c);
        glds16(src + (size_t)r * ld + c, buf + b);
    }
}

#define LDS_RD(dst, base, off) asm volatile("ds_read_b128 %0, %1 offset:" #off : "=v"(dst) : "v"(base) : "memory")
template <int MI>
DI void compute_ktile(unsigned sa, unsigned sb, f32x4 (&acc)[MI][4]) {
    bf16x8 af[2][4], bw[2][4];
    LDS_RD(af[0][0], sa, 0); if (MI > 1) LDS_RD(af[0][1], sa, 2048); if (MI > 2) LDS_RD(af[0][2], sa, 4096); if (MI > 3) LDS_RD(af[0][3], sa, 6144);
    LDS_RD(bw[0][0], sb, 0); LDS_RD(bw[0][1], sb, 2048); LDS_RD(bw[0][2], sb, 4096); LDS_RD(bw[0][3], sb, 6144);
    LDS_RD(af[1][0], sa, 1024); if (MI > 1) LDS_RD(af[1][1], sa, 3072); if (MI > 2) LDS_RD(af[1][2], sa, 5120); if (MI > 3) LDS_RD(af[1][3], sa, 7168);
    LDS_RD(bw[1][0], sb, 1024); LDS_RD(bw[1][1], sb, 3072); LDS_RD(bw[1][2], sb, 5120); LDS_RD(bw[1][3], sb, 7168);
    __builtin_amdgcn_sched_barrier(0);
    if (MI == 4) asm volatile("s_waitcnt lgkmcnt(8)" ::: "memory"); else if (MI == 3) asm volatile("s_waitcnt lgkmcnt(7)" ::: "memory"); else if (MI == 2) asm volatile("s_waitcnt lgkmcnt(6)" ::: "memory"); else asm volatile("s_waitcnt lgkmcnt(5)" ::: "memory");
    __builtin_amdgcn_sched_barrier(0);
#pragma unroll
    for (int m = 0; m < MI; ++m)
#pragma unroll
        for (int n = 0; n < 4; ++n) acc[m][n] = __builtin_amdgcn_mfma_f32_16x16x32_bf16(bw[0][n], af[0][m], acc[m][n], 0, 0, 0);
    __builtin_amdgcn_sched_barrier(0);
    asm volatile("s_waitcnt lgkmcnt(0)" ::: "memory");
    __builtin_amdgcn_sched_barrier(0);
#pragma unroll
    for (int m = 0; m < MI; ++m)
#pragma unroll
        for (int n = 0; n < 4; ++n) acc[m][n] = __builtin_amdgcn_mfma_f32_16x16x32_bf16(bw[1][n], af[1][m], acc[m][n], 0, 0, 0);
    __builtin_amdgcn_sched_barrier(0);
}
DI unsigned lds_addr(const void* p) { return (unsigned)(uintptr_t)(const __attribute__((address_space(3))) unsigned char*)p; }

template <int MI>
DI void gemm_tile(const bf16_t* A, int lda, const bf16_t* Bt, int ldb, int K, int m0, int n0, f32x4 (&acc)[MI][4], unsigned char* lds) {
    const int tid = otid(), wid = tid >> 6, lane = tid & 63, wr = wid >> 1, wc = wid & 1, fr = lane & 15, fq = lane >> 4;
#pragma unroll
    for (int m = 0; m < MI; ++m)
#pragma unroll
        for (int n = 0; n < 4; ++n) acc[m][n] = (f32x4){0.f, 0.f, 0.f, 0.f};
    const bf16_t* Ab = A + (size_t)m0 * lda;
    const bf16_t* Bb = Bt + (size_t)n0 * ldb;
    const int nt = K >> 6;
    const unsigned la = lds_addr(lds) + lds_byte(wr * (MI * 16) + fr, fq * 8), lb = lds_addr(lds) + 32768 + lds_byte(wc * 64 + fr, fq * 8);
    __syncthreads();
    stage_half<MI>(lds, Ab, lda, tid);
    stage_half<2>(lds + 32768, Bb, ldb, tid);
    stage_half<MI>(lds + 49152, Ab + 64, lda, tid);
    stage_half<2>(lds + 49152 + 32768, Bb + 64, ldb, tid);
    int cur = 0, nxt = 2;
    for (int t = 0; t < nt; ++t) {
        if (t + 1 < nt) { if (MI == 4) asm volatile("s_waitcnt vmcnt(6)" ::: "memory"); else if (MI == 3) asm volatile("s_waitcnt vmcnt(5)" ::: "memory"); else if (MI == 2) asm volatile("s_waitcnt vmcnt(4)" ::: "memory"); else asm volatile("s_waitcnt vmcnt(3)" ::: "memory"); }
        else asm volatile("s_waitcnt vmcnt(0)" ::: "memory");
        __builtin_amdgcn_sched_barrier(0);
        asm volatile("" ::: "memory");
        __builtin_amdgcn_s_barrier();
        asm volatile("" ::: "memory");
        __builtin_amdgcn_sched_barrier(0);
        if (t + 2 < nt) {
            stage_half<MI>(lds + nxt * 49152, Ab + (t + 2) * 64, lda, tid);
            stage_half<2>(lds + nxt * 49152 + 32768, Bb + (t + 2) * 64, ldb, tid);
        }
        compute_ktile<MI>(la + cur * 49152, lb + cur * 49152, acc);
        cur = (cur == 2) ? 0 : cur + 1; nxt = (nxt == 2) ? 0 : nxt + 1;
    }
}

DI void store_bf4(bf16_t* p, f32x4 v) { u32x2 w; w.x = pk(v[0], v[1]); w.y = pk(v[2], v[3]); *(u32x2*)p = w; }

DI void transpose_tile(const float* __restrict__ src, int ld_src, bf16_t* __restrict__ dst, int ld_dst, int k0, int r0, int perm, float* tile_base) {
    const int tid = otid(), lt = tid & 255;
    float* tile = tile_base + (tid >> 8) * (64 * 65);
    const int ty = lt >> 4, tx = lt & 15, nn = tx * 4;
    const int scol = perm ? ((nn >> 5) * DFF + (r0 >> 7) * 64 + ((r0 >> 6) & 1) * 32 + (nn & 31)) : (r0 + nn);
    __syncthreads();
#pragma unroll
    for (int i = 0; i < 4; ++i) {
        const int kk = ty + 16 * i;
        const f32x4 v = __builtin_nontemporal_load((const f32x4*)(src + (size_t)(k0 + kk) * ld_src + scol));
        tile[kk * 65 + nn + 0] = v[0]; tile[kk * 65 + nn + 1] = v[1]; tile[kk * 65 + nn + 2] = v[2]; tile[kk * 65 + nn + 3] = v[3];
    }
    __syncthreads();
    const int n = lt >> 2, kc = lt & 3;
    u32x4 w0, w1;
    w0.x = pk(tile[(kc * 16 + 0) * 65 + n], tile[(kc * 16 + 1) * 65 + n]);
    w0.y = pk(tile[(kc * 16 + 2) * 65 + n], tile[(kc * 16 + 3) * 65 + n]);
    w0.z = pk(tile[(kc * 16 + 4) * 65 + n], tile[(kc * 16 + 5) * 65 + n]);
    w0.w = pk(tile[(kc * 16 + 6) * 65 + n], tile[(kc * 16 + 7) * 65 + n]);
    w1.x = pk(tile[(kc * 16 + 8) * 65 + n], tile[(kc * 16 + 9) * 65 + n]);
    w1.y = pk(tile[(kc * 16 + 10) * 65 + n], tile[(kc * 16 + 11) * 65 + n]);
    w1.z = pk(tile[(kc * 16 + 12) * 65 + n], tile[(kc * 16 + 13) * 65 + n]);
    w1.w = pk(tile[(kc * 16 + 14) * 65 + n], tile[(kc * 16 + 15) * 65 + n]);
    u32x4* d = (u32x4*)(dst + (size_t)(r0 + n) * ld_dst + k0 + kc * 16);
    d[0] = w0; d[1] = w1;
}

__device__ void phase_prologue(const Params& p, unsigned char* lds) {
    const int tid = otid();
    float* tile = (float*)lds;
    bf16_t* W = (bf16_t*)(p.ws + O_W);
    constexpr int NT_W = 27136 / 2, NT_MOD = 576, NT_CK = 512, NT_CV = 512 / 2, NT_X = 768;
    constexpr int TOTAL = NT_W + NT_MOD + NT_CK + NT_CV + NT_X + 1;
    for (int it = blockIdx.x; it < TOTAL; it += gridDim.x) {
        if (it < NT_W) {
            const int it2 = it * 2 + (tid >> 8);
            const int l = it2 / 6784, r = it2 % 6784;
            int widx, ti;
            if (r < 1408) { widx = 0; ti = r; } else if (r < 2112) { widx = 1; ti = r - 1408; } else if (r < 3904) { widx = 2; ti = r - 2112; }
            else if (r < 4160) { widx = 3; ti = r - 3904; } else if (r < 4416) { widx = 4; ti = r - 4160; } else if (r < 4672) { widx = 5; ti = r - 4416; }
            else if (r < 6080) { widx = 6; ti = r - 4672; } else { widx = 7; ti = r - 6080; }
            const float* src; int K, N, perm = 0; size_t we;
            switch (widx) {
                case 0: src = p.in[9]; K = 1024; N = 5632; perm = 1; we = WE_13A; break;
                case 1: src = p.in[10]; K = 2816; N = 1024; we = WE_2A; break;
                case 2: src = p.in[11]; K = 1024; N = 7168; we = WE_IN; break;
                case 3: src = p.in[17]; K = 1024; N = 1024; we = WE_A; break;
                case 4: src = p.in[18]; K = 1024; N = 1024; we = WE_B; break;
                case 5: src = p.in[19]; K = 1024; N = 1024; we = WE_O; break;
                case 6: src = p.in[20]; K = 1024; N = 5632; perm = 1; we = WE_13B; break;
                default: src = p.in[21]; K = 2816; N = 1024; we = WE_2B; break;
            }
            const int nkt = K >> 6;
            const int nrt = N >> 6;
            const int rt = ti % nrt, kt = ti / nrt;
            transpose_tile(src + (size_t)l * K * N, N, W + (size_t)l * WE_LAYER + we, K, kt * 64, rt * 64, perm, tile);
        } else if (it < NT_W + NT_MOD) {
            const int j = it - NT_W, l = j / 144, cb = j % 144;
            const int tx = tid & 15, kg = tid >> 4;
            const float* wm = p.in[6] + (size_t)l * 1024 * 9216 + cb * 64 + tx * 4;
            f32x4 a0 = {0.f, 0.f, 0.f, 0.f}, a1 = a0, a2 = a0;
#pragma unroll 8
            for (int k = kg; k < 1024; k += 32) {
                const f32x4 w = __builtin_nontemporal_load((const f32x4*)(wm + (size_t)k * 9216));
                const float s0 = siluf_(p.in[5][k]), s1 = siluf_(p.in[4][k]), s2 = siluf_(p.in[4][1024 + k]);
                a0 += w * s0; a1 += w * s1; a2 += w * s2;
            }
            __syncthreads();
            float* red = tile;
#pragma unroll
            for (int q = 0; q < 4; ++q) { red[(kg * 3 + 0) * 64 + tx * 4 + q] = a0[q]; red[(kg * 3 + 1) * 64 + tx * 4 + q] = a1[q]; red[(kg * 3 + 2) * 64 + tx * 4 + q] = a2[q]; }
            __syncthreads();
            if (tid < 192) {
                const int c = tid >> 6, col = tid & 63;
                float s = 0.f;
#pragma unroll
                for (int g = 0; g < 32; ++g) s += red[(g * 3 + c) * 64 + col];
                const int jc = cb * 64 + col;
                ((float*)(p.ws + O_MOD))[(size_t)(l * 3 + c) * 9216 + jc] = s + p.in[7][l * 9216 + jc];
            }
        } else if (it < NT_W + NT_MOD + NT_CK) {
            const int j = it - NT_W - NT_MOD;
            const size_t e0 = (size_t)j * 4096 + tid * 8;
            const int col = (int)(e0 & 1023), key = (int)((e0 >> 10) & 255), bl = (int)(e0 >> 18), b = bl >> 2, l = bl & 3;
            const f32x4 v0 = __builtin_nontemporal_load((const f32x4*)(p.in[2] + e0)), v1 = __builtin_nontemporal_load((const f32x4*)(p.in[2] + e0 + 4));
            u32x4 w; w.x = pk(v0[0], v0[1]); w.y = pk(v0[2], v0[3]); w.z = pk(v1[0], v1[1]); w.w = pk(v1[2], v1[3]);
            *(u32x4*)((bf16_t*)(p.ws + O_KL) + ((size_t)(l * 2 + b) * 1280 + key) * 1024 + col) = w;
        } else if (it < NT_W + NT_MOD + NT_CK + NT_CV) {
            const int j = (it - NT_W - NT_MOD - NT_CK) * 2 + (tid >> 8);
            const int et = j & 1, kt = (j >> 1) & 3, h = (j >> 3) & 7, l = (j >> 6) & 3, b = j >> 8;
            const float* src = p.in[3] + ((size_t)(b * 4 + l) * 256) * 1024 + h * 128;
            bf16_t* dst = (bf16_t*)(p.ws + O_VTL) + ((size_t)((l * 2 + b) * 8 + h) * 128) * 1280;
            transpose_tile(src, 1024, dst, 1280, kt * 64, et * 64, 0, tile);
        } else if (it == TOTAL - 1) {
            float* RT = (float*)(p.ws + O_ROPE);
#pragma unroll
            for (int i = 0; i < 2; ++i) {
                const int e = tid + i * 512, pos = e >> 4, fi = e & 15;
                const float ang = (float)pos * fexp2(-(float)fi * 0.8304820237f);
                float rev = ang * 0.15915494309f; rev -= floorf(rev);
                RT[e] = __builtin_amdgcn_cosf(rev); RT[1024 + e] = __builtin_amdgcn_sinf(rev);
            }
        } else {
            const int j = it - NT_W - NT_MOD - NT_CK - NT_CV;
            float* X = (float*)(p.ws + O_X);
#pragma unroll
            for (int i = 0; i < 4; ++i) {
                const size_t e = (size_t)j * 8192 + i * 2048 + tid * 4;
                const f32x4 v = (e < (size_t)RC * D) ? *(const f32x4*)(p.in[0] + e) : *(const f32x4*)(p.in[1] + (e - (size_t)RC * D));
                *(f32x4*)(X + e) = v;
            }
        }
    }
}

__device__ void phase_norm(const Params& p, int l, int which) {
    const int tid_ = otid(); const int lane = tid_ & 63, wid = tid_ >> 6;
    const float* X = (const float*)(p.ws + O_X);
    const float* MOD = (const float*)(p.ws + O_MOD);
    bf16_t* H = (bf16_t*)(p.ws + O_H);
    const int gw = blockIdx.x * 8 + wid, nw = gridDim.x * 8;
    for (int row0 = gw; row0 < R; row0 += 3 * nw) {
        f32x4 v[3][4];
#pragma unroll
        for (int j = 0; j < 3; ++j) {
            const int row = row0 + j * nw;
            if (row < R) {
#pragma unroll
                for (int i = 0; i < 4; ++i) v[j][i] = *(const f32x4*)(X + (size_t)row * D + i * 256 + lane * 4);
            }
        }
#pragma unroll
        for (int j = 0; j < 3; ++j) {
            const int row = row0 + j * nw;
            if (row < R) {
                float ss = 0.f;
#pragma unroll
                for (int i = 0; i < 4; ++i) ss += v[j][i][0] * v[j][i][0] + v[j][i][1] * v[j][i][1] + v[j][i][2] * v[j][i][2] + v[j][i][3] * v[j][i][3];
#pragma unroll
                for (int o = 32; o >= 1; o >>= 1) ss += __shfl_xor(ss, o);
                const float r = __builtin_amdgcn_rsqf(ss * (1.f / 1024.f) + EPS);
                if (which < 3) {
                    const float* g = p.in[8] + (size_t)(l * 3 + which) * D;
                    const float* md = MOD + (size_t)(l * 3 + cond_of_row(row)) * 9216 + (size_t)(3 * which) * D;
#pragma unroll
                    for (int i = 0; i < 4; ++i) {
                        const int c = i * 256 + lane * 4;
                        const f32x4 gg = *(const f32x4*)(g + c), sh = *(const f32x4*)(md + c), sc = *(const f32x4*)(md + D + c);
                        store_bf4(H + (size_t)row * D + c, (v[j][i] * r) * gg * (sc + 1.f) + sh);
                    }
                } else {
#pragma unroll
                    for (int i = 0; i < 4; ++i) {
                        const int c = i * 256 + lane * 4;
                        *(f32x4*)(p.out + (size_t)row * D + c) = (v[j][i] * r) * (*(const f32x4*)(p.in[22] + c));
                    }
                }
            }
        }
    }
}

enum { G_UP = 0, G_DOWN = 1, G_WIN = 2, G_BR = 3, G_OUT = 4 };

template <int KIND, int MI>
DI void gemm_item(const Params& p, int l, int second, int m0, int ntile, unsigned char* lds) {
    const int tid = otid(), wid = tid >> 6, lane = tid & 63, wr = wid >> 1, wc = wid & 1, fr = lane & 15, fq = lane >> 4;
    const bf16_t* W = (const bf16_t*)(p.ws + O_W) + (size_t)l * WE_LAYER;
    const float* MOD = (const float*)(p.ws + O_MOD);
    float* X = (float*)(p.ws + O_X);
    const bf16_t* H = (const bf16_t*)(p.ws + O_H);
    bf16_t* ACT = (bf16_t*)(p.ws + O_ACT);
    constexpr int WMR = MI * 16;
    const int n0 = ntile * 128;
    {
        f32x4 acc[MI][4];
        if (KIND == G_UP) {
            gemm_tile<MI>(H, D, W + (second ? WE_13B : WE_13A), D, D, m0, n0, acc, lds);
#pragma unroll
            for (int m = 0; m < MI; ++m) {
                const int row = m0 + wr * WMR + m * 16 + fr;
#pragma unroll
                for (int nn = 0; nn < 2; ++nn) {
                    f32x4 o;
#pragma unroll
                    for (int j = 0; j < 4; ++j) o[j] = siluf_(acc[m][nn][j]) * acc[m][nn + 2][j];
                    store_bf4(ACT + (size_t)row * DFF + ntile * 64 + wc * 32 + nn * 16 + fq * 4, o);
                }
            }
        } else if (KIND == G_DOWN || KIND == G_OUT) {
            if (KIND == G_DOWN) gemm_tile<MI>(ACT, DFF, W + (second ? WE_2B : WE_2A), DFF, DFF, m0, n0, acc, lds);
            else gemm_tile<MI>((const bf16_t*)(p.ws + O_MG), D, W + WE_O, D, D, m0, n0, acc, lds);
            const int slot = (KIND == G_OUT) ? 5 : (second ? 8 : 2);
            const float scl = (KIND == G_OUT) ? 1.f : 0.5f;
#pragma unroll
            for (int m = 0; m < MI; ++m) {
                const int row = m0 + wr * WMR + m * 16 + fr;
                const float* gt = MOD + (size_t)(l * 3 + cond_of_row(row)) * 9216 + (size_t)slot * D;
#pragma unroll
                for (int n = 0; n < 4; ++n) {
                    const int col = n0 + wc * 64 + n * 16 + fq * 4;
                    const f32x4 g = *(const f32x4*)(gt + col) * scl;
                    f32x4* xp = (f32x4*)(X + (size_t)row * D + col);
                    *xp = *xp + g * acc[m][n];
                }
            }
        } else if (KIND == G_BR) {
            const bf16_t* SG = (const bf16_t*)(p.ws + O_SG);
            gemm_tile<MI>((const bf16_t*)(p.ws + O_ABR), D, W + WE_A, D, D, m0, n0, acc, lds);
            float* MG1 = (float*)(p.ws + O_MG1);
#pragma unroll
            for (int m = 0; m < MI; ++m) {
                const int row = m0 + wr * WMR + m * 16 + fr;
#pragma unroll
                for (int n = 0; n < 4; ++n) {
                    const int col = n0 + wc * 64 + n * 16 + fq * 4;
                    const u32x2 gv = *(const u32x2*)(SG + (size_t)row * 2048 + col);
                    f32x4 g; g[0] = __uint_as_float(gv.x << 16); g[1] = __uint_as_float(gv.x & 0xffff0000u); g[2] = __uint_as_float(gv.y << 16); g[3] = __uint_as_float(gv.y & 0xffff0000u);
                    *(f32x4*)(MG1 + (size_t)row * D + col) = g * acc[m][n];
                }
            }
            gemm_tile<MI>((const bf16_t*)(p.ws + O_BBR), D, W + WE_B, D, D, m0, n0, acc, lds);
            bf16_t* MG = (bf16_t*)(p.ws + O_MG);
#pragma unroll
            for (int m = 0; m < MI; ++m) {
                const int row = m0 + wr * WMR + m * 16 + fr;
#pragma unroll
                for (int n = 0; n < 4; ++n) {
                    const int col = n0 + wc * 64 + n * 16 + fq * 4;
                    const u32x2 gv = *(const u32x2*)(SG + (size_t)row * 2048 + 1024 + col);
                    f32x4 g; g[0] = __uint_as_float(gv.x << 16); g[1] = __uint_as_float(gv.x & 0xffff0000u); g[2] = __uint_as_float(gv.y << 16); g[3] = __uint_as_float(gv.y & 0xffff0000u);
                    const f32x4 m1 = *(const f32x4*)(MG1 + (size_t)row * D + col);
                    store_bf4(MG + (size_t)row * D + col, m1 + g * acc[m][n]);
                }
            }
        } else {
            gemm_tile<MI>(H, D, W + WE_IN, D, D, m0, n0, acc, lds);
            const bool ctx = m0 < RC;
            const int b = ctx ? (m0 >> 8) : ((m0 - RC) >> 10);
            const int pos0 = (ctx ? (m0 & 255) : ((m0 - RC) & 1023)) + wr * WMR;
            if (n0 < 1024) {
                bf16_t* U = (bf16_t*)(p.ws + O_U);
#pragma unroll
                for (int m = 0; m < MI; ++m)
#pragma unroll
                    for (int n = 0; n < 4; ++n) {
                        f32x4 o;
#pragma unroll
                        for (int j = 0; j < 4; ++j) o[j] = geluf_(acc[m][n][j]);
                        store_bf4(U + (size_t)(m0 + wr * WMR + m * 16 + fr) * D + n0 + wc * 64 + n * 16 + fq * 4, o);
                    }
            } else if (n0 < 2048) {
                bf16_t* VT = (bf16_t*)(p.ws + O_VT);
                float* VSS = (float*)(p.ws + O_VSS);
#pragma unroll
                for (int m = 0; m < MI; ++m) {
                    const int row = m0 + wr * WMR + m * 16 + fr;
                    float ss = 0.f;
#pragma unroll
                    for (int n = 0; n < 4; ++n)
#pragma unroll
                        for (int j = 0; j < 4; ++j) {
                            const float gq = bfround(geluf_(acc[m][n][j]));
                            ss += gq * gq;
                            const int ch = n0 - 1024 + wc * 64 + n * 16 + fq * 4 + j;
                            VT[(size_t)ch * R + row] = (bf16_t)(__float_as_uint(gq) >> 16);
                        }
                    ss += __shfl_xor(ss, 16); ss += __shfl_xor(ss, 32);
                    if (fq == 0) VSS[(size_t)row * 16 + ((n0 - 1024) >> 7) * 2 + wc] = ss;
                }
            } else if (n0 < 4096) {
                const bool isq = n0 < 3072;
                const int cb = (isq ? n0 - 2048 : n0 - 3072) + wc * 64;
                if (!isq && ctx) {
                    float* ok = p.out + (size_t)R * D + ((size_t)(b * 4 + l) * 256) * 1024;
#pragma unroll
                    for (int m = 0; m < MI; ++m) {
#pragma unroll
                        for (int n = 0; n < 4; ++n) __builtin_nontemporal_store(acc[m][n], (f32x4*)(ok + (size_t)(pos0 + m * 16 + fr) * 1024 + cb + n * 16 + fq * 4));
                        __builtin_amdgcn_sched_barrier(0);
                    }
                    __builtin_amdgcn_sched_barrier(0);
                }
                if (!ctx) {
                    const float* RC_ = (const float*)(p.ws + O_ROPE);
                    const f32x4 cr = *(const f32x4*)(RC_ + (pos0 >> 6) * 16 + fq * 4), sr = *(const f32x4*)(RC_ + 1024 + (pos0 >> 6) * 16 + fq * 4);
#pragma unroll
                    for (int m = 0; m < MI; ++m) {
                        const int gc = (pos0 & 63) + m * 16 + fr;
                        const f32x4 cc = *(const f32x4*)(RC_ + gc * 16 + fq * 4), sc = *(const f32x4*)(RC_ + 1024 + gc * 16 + fq * 4);
                        const f32x4 x1 = acc[m][0], x2 = acc[m][1], y1 = acc[m][2], y2 = acc[m][3];
                        acc[m][0] = x1 * cr - x2 * sr; acc[m][1] = x2 * cr + x1 * sr;
                        acc[m][2] = y1 * cc - y2 * sc; acc[m][3] = y2 * cc + y1 * sc;
                    }
                }
                bf16_t* dst; size_t rowbase;
                if (isq) { dst = (bf16_t*)(p.ws + O_Q); rowbase = (size_t)(m0 + wr * WMR); }
                else if (ctx) { dst = (bf16_t*)(p.ws + O_KC); rowbase = (size_t)(m0 + wr * WMR); }
                else { dst = (bf16_t*)(p.ws + O_KL); rowbase = (size_t)(l * 2 + b) * 1280 + 256 + pos0; }
                const float qs = isq ? 0.18033688011f : 1.f;
#pragma unroll
                for (int m = 0; m < MI; ++m) {
#pragma unroll
                    for (int n = 0; n < 4; ++n) store_bf4(dst + (rowbase + m * 16 + fr) * 1024 + cb + n * 16 + fq * 4, acc[m][n] * qs);
                    __builtin_amdgcn_sched_barrier(0);
                }
            } else if (n0 < 5120) {
                const int h = (n0 - 4096) >> 7;
                if (ctx) {
                    float* ov = p.out + (size_t)R * D + (size_t)16 * 4 * 256 * 1024 + ((size_t)(b * 4 + l) * 256) * 1024;
#pragma unroll
                    for (int m = 0; m < MI; ++m)
#pragma unroll
                        for (int n = 0; n < 4; ++n) __builtin_nontemporal_store(acc[m][n], (f32x4*)(ov + (size_t)(pos0 + m * 16 + fr) * 1024 + (n0 - 4096) + wc * 64 + n * 16 + fq * 4));
                }
                bf16_t* vt; int ldv, koff;
                if (ctx) { vt = (bf16_t*)(p.ws + O_VTC) + ((size_t)(b * 8 + h) * 128) * 256; ldv = 256; koff = pos0; }
                else { vt = (bf16_t*)(p.ws + O_VTL) + ((size_t)((l * 2 + b) * 8 + h) * 128) * 1280; ldv = 1280; koff = 256 + pos0; }
#pragma unroll
                for (int m = 0; m < MI; ++m)
#pragma unroll
                    for (int n = 0; n < 4; ++n)
#pragma unroll
                        for (int j = 0; j < 4; ++j) {
                            const int e = wc * 64 + n * 16 + fq * 4 + j;
                            vt[(size_t)e * ldv + koff + m * 16 + fr] = (bf16_t)(pk(acc[m][n][j], 0.f) & 0xffffu);
                            if (j == 3) __builtin_amdgcn_sched_barrier(0);
                        }
            } else {
                bf16_t* SG = (bf16_t*)(p.ws + O_SG);
#pragma unroll
                for (int m = 0; m < MI; ++m)
#pragma unroll
                    for (int n = 0; n < 4; ++n) {
                        f32x4 o;
#pragma unroll
                        for (int j = 0; j < 4; ++j) o[j] = sigmoidf_(acc[m][n][j]);
                        store_bf4(SG + (size_t)(m0 + wr * WMR + m * 16 + fr) * 2048 + (n0 - 5120) + wc * 64 + n * 16 + fq * 4, o);
                    }
            }
        }
    }
}

template <int KIND>
__device__ void phase_gemm(const Params& p, int l, int second, unsigned char* lds) {
    const int G = (int)gridDim.x, bid = (int)blockIdx.x;
    if (KIND == G_UP || KIND == G_WIN) {
        const int NTN = (KIND == G_UP) ? 44 : 56, ntiles = 24 * NTN;
        if ((G & 7) == 0) {
            const int x = bid & 7, lb = bid >> 3, nb = G >> 3, mx = x & 3, nx = x >> 2, npx = NTN >> 1, nloc = 6 * npx;
            const int nfull = (nloc / nb) * nb, nrem = nloc - nfull;
            for (int j = lb; j < nfull; j += nb) gemm_item<KIND, 4>(p, l, second, (mx * 6 + j % 6) * 256, nx * npx + j / 6, lds);
            for (int q = lb; q < nrem * 4; q += nb) { const int j = nfull + (q >> 2); gemm_item<KIND, 1>(p, l, second, (mx * 6 + j % 6) * 256 + (q & 3) * 64, nx * npx + j / 6, lds); }
        } else {
            const int nfull = (ntiles / G) * G, nrem = ntiles - nfull;
            for (int t = bid; t < nfull; t += G) gemm_item<KIND, 4>(p, l, second, (t % 24) * 256, t / 24, lds);
            for (int j = bid; j < nrem * 4; j += G) { const int t = nfull + (j >> 2); gemm_item<KIND, 1>(p, l, second, (t % 24) * 256 + (j & 3) * 64, t / 24, lds); }
        }
    } else {
        for (int t = bid; t < 32 * 8; t += G) gemm_item<KIND, 3>(p, l, second, (t % 32) * 192, t / 32, lds);
    }
}

__device__ void spatial_item(const Params& p, int l, int item, unsigned char* lds) {
    const int tid = otid(), wid = tid >> 6, lane = tid & 63, wr = wid >> 2, wc = wid & 3, fr = lane & 15, fq = lane >> 4;
    const int g = item & 3, ck = item >> 2;
    const int m0 = ck * 128, c0 = g * 256;
    const bf16_t* VT = (const bf16_t*)(p.ws + O_VT);
    const float* VSS = (const float*)(p.ws + O_VSS);
    float* rstd = (float*)(lds + LDS_X);
    __syncthreads();
    if (tid < 128) {
        const f32x4* q = (const f32x4*)(VSS + (size_t)(m0 + tid) * 16);
        const f32x4 a = q[0] + q[1] + q[2] + q[3];
        rstd[tid] = __builtin_amdgcn_rsqf((a[0] + a[1] + a[2] + a[3]) * (1.f / 1024.f) + EPS);
    }
    stage_half<4>(lds + 32768, VT + (size_t)c0 * R + m0, R, tid);
    stage_half<4>(lds + 65536, VT + (size_t)c0 * R + m0 + 64, R, tid);
    __syncthreads();
    const float* ws = p.in[13] + (size_t)(l * 4 + g) * 128 * 128;
#pragma unroll
    for (int t = 0; t < 2; ++t)
#pragma unroll
        for (int i = 0; i < 2; ++i) {
            const int b = tid * 16 + i * 8192; int r, c; stage_rc(b, r, c);
            const f32x4 v0 = *(const f32x4*)(ws + r * 128 + t * 64 + c), v1 = *(const f32x4*)(ws + r * 128 + t * 64 + c + 4);
            const float* rs = rstd + t * 64 + c;
            u32x4 w; w.x = pk(v0[0] * rs[0], v0[1] * rs[1]); w.y = pk(v0[2] * rs[2], v0[3] * rs[3]); w.z = pk(v1[0] * rs[4], v1[1] * rs[5]); w.w = pk(v1[2] * rs[6], v1[3] * rs[7]);
            *(u32x4*)(lds + t * 16384 + b) = w;
        }
    WAIT_VM0();
    __syncthreads();
    f32x4 acc[4][4];
#pragma unroll
    for (int m = 0; m < 4; ++m)
#pragma unroll
        for (int n = 0; n < 4; ++n) acc[m][n] = (f32x4){0.f, 0.f, 0.f, 0.f};
    { const unsigned la = lds_addr(lds) + lds_byte(wr * 64 + fr, fq * 8), lb = lds_addr(lds) + 32768 + lds_byte(wc * 64 + fr, fq * 8);
      compute_ktile<4>(la, lb, acc);
      compute_ktile<4>(la + 16384, lb + 32768, acc); }
    const bf16_t* U = (const bf16_t*)(p.ws + O_U);
    bf16_t* ABR = (bf16_t*)(p.ws + O_ABR);
    const float* gain = p.in[12] + (size_t)l * D;
    const float* bs = p.in[14] + (size_t)(l * 4 + g) * 128;
#pragma unroll
    for (int m = 0; m < 4; ++m) {
        const int pr = wr * 64 + m * 16 + fr;
        const float bias = bs[pr];
#pragma unroll
        for (int n = 0; n < 4; ++n) {
            const int col = c0 + wc * 64 + n * 16 + fq * 4;
            const f32x4 gn = *(const f32x4*)(gain + col);
            const u32x2 uv = *(const u32x2*)(U + (size_t)(m0 + pr) * D + col);
            f32x4 u; u[0] = __uint_as_float(uv.x << 16); u[1] = __uint_as_float(uv.x & 0xffff0000u); u[2] = __uint_as_float(uv.y << 16); u[3] = __uint_as_float(uv.y & 0xffff0000u);
            store_bf4(ABR + (size_t)(m0 + pr) * D + col, u * (gn * acc[m][n] + bias));
        }
    }
}

__device__ void attn_item(const Params& p, int l, bool ctx, int b, int h, int qt, unsigned char* lds) {
    const int tid = otid(), wid = tid >> 6, lane = tid & 63, fr = lane & 15, fq = lane >> 4;
    const int qrow0 = (ctx ? b * 256 : RC + b * 1024) + qt * 128 + wid * 16;
    const bf16_t* Kb = ctx ? (const bf16_t*)(p.ws + O_KC) + (size_t)(b * 256) * 1024 + h * 128
                           : (const bf16_t*)(p.ws + O_KL) + ((size_t)(l * 2 + b) * 1280) * 1024 + h * 128;
    const int ldv = ctx ? 256 : 1280;
    const bf16_t* Vb = ctx ? (const bf16_t*)(p.ws + O_VTC) + ((size_t)(b * 8 + h) * 128) * 256
                           : (const bf16_t*)(p.ws + O_VTL) + ((size_t)((l * 2 + b) * 8 + h) * 128) * 1280;
    const int nt = ctx ? 4 : 20;
    const float* lp = p.in[15] + (size_t)l * 256;
    float e1 = lp[lane] * lp[64 + lane], e2 = lp[128 + lane] * lp[192 + lane];
#pragma unroll
    for (int o = 32; o >= 1; o >>= 1) { e1 += __shfl_xor(e1, o); e2 += __shfl_xor(e2, o); }
    const float lam_init = 0.8f - 0.6f * fexp(-0.3f * (float)l);
    const float lam = fexp(e1) - fexp(e2) + lam_init;
    const bf16_t* Q = (const bf16_t*)(p.ws + O_Q) + (size_t)(qrow0 + fr) * 1024 + h * 128;
    bf16x8 qf[2][2];
#pragma unroll
    for (int i2 = 0; i2 < 2; ++i2)
#pragma unroll
        for (int ks = 0; ks < 2; ++ks) qf[i2][ks] = *(const bf16x8*)(Q + i2 * 64 + ks * 32 + fq * 8);
    f32x4 O1[8], O2[8];
#pragma unroll
    for (int e = 0; e < 8; ++e) { O1[e] = (f32x4){0.f, 0.f, 0.f, 0.f}; O2[e] = O1[e]; }
    float mrun[2] = {-1e30f, -1e30f}, lsum[2] = {0.f, 0.f};

    __syncthreads();
#define STAGE_KV(s, t)                                                                                             \
    do {                                                                                                           \
        _Pragma("unroll") for (int i = 0; i < 2; ++i) {                                                            \
            const int P = tid + i * 512;                                                                           \
            const int key = P >> 4, c = (P & 15) ^ (key & 15);                                                     \
            glds16(Kb + (size_t)((t) * 64 + key) * 1024 + c * 8, lds + (s) * 32768 + P * 16);                      \
        }                                                                                                          \
        _Pragma("unroll") for (int i = 0; i < 2; ++i) {                                                            \
            const int P = tid + i * 512;                                                                           \
            const int e = P >> 3, c = (P & 7) ^ ((e >> 1) & 7);                                                    \
            glds16(Vb + (size_t)e * ldv + (t) * 64 + c * 8, lds + (s) * 32768 + 16384 + P * 16);                   \
        }                                                                                                          \
    } while (0)
    unsigned aK[2][2], aV[2][2];
    {
        const unsigned lb0 = lds_addr(lds), sw = (unsigned)(fr >> 1) & 7u;
#pragma unroll
        for (int i2 = 0; i2 < 2; ++i2)
#pragma unroll
            for (int ks = 0; ks < 2; ++ks) aK[i2][ks] = lb0 + fr * 256 + ((((unsigned)(i2 * 8 + ks * 4 + fq)) ^ (unsigned)fr) << 4);
#pragma unroll
        for (int kk = 0; kk < 2; ++kk)
#pragma unroll
            for (int h2 = 0; h2 < 2; ++h2) aV[kk][h2] = lb0 + 16384 + fr * 128 + ((((unsigned)(kk * 4 + (fq >> 1) + 2 * h2)) ^ sw) << 4) + (fq & 1) * 8;
    }
#define LDS_RD64(dst, base, off) asm volatile("ds_read_b64 %0, %1 offset:" #off : "=v"(dst) : "v"(base) : "memory")
    STAGE_KV(0, 0); STAGE_KV(1, 1);
    int cur = 0, nxt = 2;
    for (int t = 0; t < nt; ++t) {
        if (t + 1 < nt) asm volatile("s_waitcnt vmcnt(4)" ::: "memory"); else asm volatile("s_waitcnt vmcnt(0)" ::: "memory");
        __builtin_amdgcn_sched_barrier(0);
        asm volatile("" ::: "memory");
        __builtin_amdgcn_s_barrier();
        asm volatile("" ::: "memory");
        __builtin_amdgcn_sched_barrier(0);
        if (t + 2 < nt) STAGE_KV(nxt, t + 2);
        const unsigned off = (unsigned)cur * 32768u;
        cur = (cur == 2) ? 0 : cur + 1; nxt = (nxt == 2) ? 0 : nxt + 1;
        f32x4 s[2][4];
        {
            bf16x8 kf[2][4][2];
            const unsigned k00 = aK[0][0] + off, k01 = aK[0][1] + off, k10 = aK[1][0] + off, k11 = aK[1][1] + off;
            LDS_RD(kf[0][0][0], k00, 0); LDS_RD(kf[0][0][1], k01, 0); LDS_RD(kf[0][1][0], k00, 4096); LDS_RD(kf[0][1][1], k01, 4096);
            LDS_RD(kf[0][2][0], k00, 8192); LDS_RD(kf[0][2][1], k01, 8192); LDS_RD(kf[0][3][0], k00, 12288); LDS_RD(kf[0][3][1], k01, 12288);
            LDS_RD(kf[1][0][0], k10, 0); LDS_RD(kf[1][0][1], k11, 0); LDS_RD(kf[1][1][0], k10, 4096); LDS_RD(kf[1][1][1], k11, 4096);
            LDS_RD(kf[1][2][0], k10, 8192); LDS_RD(kf[1][2][1], k11, 8192); LDS_RD(kf[1][3][0], k10, 12288); LDS_RD(kf[1][3][1], k11, 12288);
            __builtin_amdgcn_sched_barrier(0);
            asm volatile("s_waitcnt lgkmcnt(8)" ::: "memory");
            __builtin_amdgcn_sched_barrier(0);
#pragma unroll
            for (int kt = 0; kt < 4; ++kt) {
                s[0][kt] = __builtin_amdgcn_mfma_f32_16x16x32_bf16(kf[0][kt][0], qf[0][0], (f32x4){0.f, 0.f, 0.f, 0.f}, 0, 0, 0);
                s[0][kt] = __builtin_amdgcn_mfma_f32_16x16x32_bf16(kf[0][kt][1], qf[0][1], s[0][kt], 0, 0, 0);
            }
            __builtin_amdgcn_sched_barrier(0);
            asm volatile("s_waitcnt lgkmcnt(0)" ::: "memory");
            __builtin_amdgcn_sched_barrier(0);
#pragma unroll
            for (int kt = 0; kt < 4; ++kt) {
                s[1][kt] = __builtin_amdgcn_mfma_f32_16x16x32_bf16(kf[1][kt][0], qf[1][0], (f32x4){0.f, 0.f, 0.f, 0.f}, 0, 0, 0);
                s[1][kt] = __builtin_amdgcn_mfma_f32_16x16x32_bf16(kf[1][kt][1], qf[1][1], s[1][kt], 0, 0, 0);
            }
            __builtin_amdgcn_sched_barrier(0);
        }
        bf16x8 pf[2][2];
#pragma unroll
        for (int i2 = 0; i2 < 2; ++i2) {
            float mx = -1e30f;
#pragma unroll
            for (int kt = 0; kt < 4; ++kt)
#pragma unroll
                for (int j = 0; j < 4; ++j) mx = fmaxf(mx, s[i2][kt][j]);
            if (__builtin_amdgcn_ballot_w64(mx > mrun[i2] + 8.f) != 0) {
                mx = fmaxf(mx, __shfl_xor(mx, 16)); mx = fmaxf(mx, __shfl_xor(mx, 32));
                const float mn = fmaxf(mrun[i2], mx);
                const float alpha = fexp2(mrun[i2] - mn);
                mrun[i2] = mn;
                lsum[i2] *= alpha;
                if (i2 == 0) {
#pragma unroll
                    for (int e = 0; e < 8; ++e) O1[e] = O1[e] * alpha;
                } else {
#pragma unroll
                    for (int e = 0; e < 8; ++e) O2[e] = O2[e] * alpha;
                }
            }
            const float mn = mrun[i2];
            float ps = 0.f;
#pragma unroll
            for (int kt = 0; kt < 4; ++kt)
#pragma unroll
                for (int j = 0; j < 4; ++j) { const float pv = fexp2(s[i2][kt][j] - mn); s[i2][kt][j] = pv; ps += pv; }
            lsum[i2] += ps;
#pragma unroll
            for (int kk = 0; kk < 2; ++kk) {
                u32x4 w;
                w.x = pk(s[i2][2 * kk][0], s[i2][2 * kk][1]); w.y = pk(s[i2][2 * kk][2], s[i2][2 * kk][3]);
                w.z = pk(s[i2][2 * kk + 1][0], s[i2][2 * kk + 1][1]); w.w = pk(s[i2][2 * kk + 1][2], s[i2][2 * kk + 1][3]);
                pf[i2][kk] = __builtin_bit_cast(bf16x8, w);
            }
        }
        {
            const unsigned v00 = aV[0][0] + off, v01 = aV[0][1] + off, v10 = aV[1][0] + off, v11 = aV[1][1] + off;
            u32x2 vl[8][2], vh[8][2];
#define RDV(et, o) do { LDS_RD64(vl[et][0], v00, o); LDS_RD64(vh[et][0], v01, o); LDS_RD64(vl[et][1], v10, o); LDS_RD64(vh[et][1], v11, o); } while (0)
#define PV_STEP(et, WAITN) do { __builtin_amdgcn_sched_barrier(0); asm volatile("s_waitcnt lgkmcnt(" #WAITN ")" ::: "memory"); __builtin_amdgcn_sched_barrier(0); \
            _Pragma("unroll") for (int kk = 0; kk < 2; ++kk) { u32x4 w; w.x = vl[et][kk].x; w.y = vl[et][kk].y; w.z = vh[et][kk].x; w.w = vh[et][kk].y; \
                const bf16x8 vf = __builtin_bit_cast(bf16x8, w); \
                O1[et] = __builtin_amdgcn_mfma_f32_16x16x32_bf16(vf, pf[0][kk], O1[et], 0, 0, 0); O2[et] = __builtin_amdgcn_mfma_f32_16x16x32_bf16(vf, pf[1][kk], O2[et], 0, 0, 0); } \
            __builtin_amdgcn_sched_barrier(0); } while (0)
            RDV(0, 0); RDV(1, 2048); RDV(2, 4096);
            PV_STEP(0, 8); RDV(3, 6144);
            PV_STEP(1, 8); RDV(4, 8192);
            PV_STEP(2, 8); RDV(5, 10240);
            PV_STEP(3, 8); RDV(6, 12288);
            PV_STEP(4, 8); RDV(7, 14336);
            PV_STEP(5, 8);
            PV_STEP(6, 4);
            PV_STEP(7, 0);
#undef PV_STEP
#undef RDV
        }
    }
#undef STAGE_KV
    float l1 = lsum[0], l2 = lsum[1];
    l1 += __shfl_xor(l1, 16); l1 += __shfl_xor(l1, 32);
    l2 += __shfl_xor(l2, 16); l2 += __shfl_xor(l2, 32);
    const float i1 = 1.f / l1, i2s = lam / l2;
    float ss = 0.f;
#pragma unroll
    for (int e = 0; e < 8; ++e) {
        O1[e] = O1[e] * i1 - O2[e] * i2s;
        ss += O1[e][0] * O1[e][0] + O1[e][1] * O1[e][1] + O1[e][2] * O1[e][2] + O1[e][3] * O1[e][3];
    }
    ss += __shfl_xor(ss, 16); ss += __shfl_xor(ss, 32);
    const float rn = __builtin_amdgcn_rsqf(ss * (1.f / 128.f) + EPS) * (1.f - lam_init);
    const float* sg = p.in[16] + (size_t)l * 128;
    bf16_t* BBR = (bf16_t*)(p.ws + O_BBR) + (size_t)(qrow0 + fr) * 1024 + h * 128;
#pragma unroll
    for (int e = 0; e < 8; ++e) {
        const f32x4 gn = *(const f32x4*)(sg + e * 16 + fq * 4);
        store_bf4(BBR + e * 16 + fq * 4, O1[e] * rn * gn);
    }
}

__device__ void phase_mix(const Params& p, int l, unsigned char* lds) {
    constexpr int NQ = 16 + 32 + 24;
    unsigned* ctr = (unsigned*)(p.ws + O_BAR + 14336) + l * 128;
    volatile int* slot = (volatile int*)(lds + LDS_X + 528);
    const int x0 = (int)(__builtin_amdgcn_s_getreg((3 << 11) | 20) & 7u);
    for (int dq = 0; dq < 8; ++dq) {
        const int q = (x0 + dq) & 7;
        for (;;) {
            __syncthreads();
            if (threadIdx.x == 0) *slot = (int)__hip_atomic_fetch_add(ctr + q * 16, 1u, __ATOMIC_RELAXED, __HIP_MEMORY_SCOPE_AGENT);
            __syncthreads();
            const int k = *slot;
            if (k >= NQ) break;
            if (k < 16) attn_item(p, l, false, k >> 3, q, k & 7, lds);
            else if (k < 48) attn_item(p, l, true, (k - 16) >> 1, q, (k - 16) & 1, lds);
            else spatial_item(p, l, q * 24 + (k - 48), lds);
        }
    }
}

#define XB_TMO      128
#define XB_XCNT(j)  (256  + 64 * (j))
#define XB_XSUB(j)  (1280 + 64 * (j))
#define XB_XGEN(j)  (2304 + 64 * (j))
#define XB_TOP      3328
#define XB_TOPGEN   3392
#define XCD_BAR_WORDS 3456
#define XB_SPIN_CAP (1u << 18)
#define LAS __attribute__((address_space(3)))

__device__ __forceinline__ unsigned xb_ld(unsigned* p)              { return __hip_atomic_load(p, __ATOMIC_RELAXED, __HIP_MEMORY_SCOPE_AGENT); }
__device__ __forceinline__ unsigned xb_add(unsigned* p, unsigned v) { return __hip_atomic_fetch_add(p, v, __ATOMIC_RELAXED, __HIP_MEMORY_SCOPE_AGENT); }
__device__ __forceinline__ unsigned xb_xcc_id() { return (unsigned)__builtin_amdgcn_s_getreg((3 << 11) | 20) & 0xFu; }
#define XB_SPIN(cond, bar) do { unsigned _sp = 0; while (cond) { __builtin_amdgcn_s_sleep(1); \
    if ((++_sp & 255u) == 0u) { if (xb_ld(&(bar)[XB_TMO])) break; if (_sp > XB_SPIN_CAP) { atomicAdd(&(bar)[XB_TMO], 1u); break; } } } } while (0)

struct XcdBarrier {
    unsigned* bar; unsigned x;
    volatile LAS unsigned* st;
};

__device__ __forceinline__ XcdBarrier xcd_barrier_post(unsigned* bar, volatile LAS unsigned* st) {
    XcdBarrier b; b.bar = bar; b.x = xb_xcc_id(); b.st = st;
    if (threadIdx.x == 0) (void)xb_add(&bar[XB_XCNT(b.x)], 1u);
    return b;
}
__device__ __forceinline__ void xcd_barrier_complete(unsigned* bar, unsigned x, unsigned& nloc, unsigned& nx) {
    const unsigned G = gridDim.x * gridDim.y * gridDim.z;
    unsigned sum, cnt, mine, sp = 0u;
    for (;;) {
        sum = 0u; cnt = 0u; mine = 0u;
#pragma unroll
        for (unsigned j = 0; j < 16; ++j) { const unsigned c = xb_ld(&bar[XB_XCNT(j)]); sum += c; cnt += (c > 0u) ? 1u : 0u; mine = (j == x) ? c : mine; }
        if (sum == G) break;
        __builtin_amdgcn_s_sleep(1);
        if ((++sp & 255u) == 0u) { if (xb_ld(&bar[XB_TMO])) break; if (sp > XB_SPIN_CAP) { atomicAdd(&bar[XB_TMO], 1u); break; } }
    }
    nloc = mine > 0u ? mine : 1u; nx = cnt > 0u ? cnt : 1u;
}

__device__ __forceinline__ void xcd_barrier(const XcdBarrier& b) {
    asm volatile("s_waitcnt vmcnt(0)" ::: "memory");
    __syncthreads();
    if (threadIdx.x == 0) {
        unsigned* bar = b.bar;
        __builtin_amdgcn_s_waitcnt(0);
        unsigned nloc = b.st[0], nx = b.st[1];
        if (nloc == 0u) { xcd_barrier_complete(bar, b.x, nloc, nx); b.st[0] = nloc; b.st[1] = nx; }
        const unsigned old = xb_add(&bar[XB_XSUB(b.x)], 1u);
        const unsigned gen = old / nloc;
        if (old + 1u == (gen + 1u) * nloc) {
            __builtin_amdgcn_fence(__ATOMIC_RELEASE, "agent");
            asm volatile("s_waitcnt vmcnt(0)" ::: "memory");
            const unsigned og = xb_add(&bar[XB_TOP], 1u);
            const unsigned tg = og / nx;
            if (og + 1u == (tg + 1u) * nx) xb_add(&bar[XB_TOPGEN], 1u);
            else XB_SPIN(xb_ld(&bar[XB_TOPGEN]) == tg, bar);
            __builtin_amdgcn_fence(__ATOMIC_ACQUIRE, "agent");
            xb_add(&bar[XB_XGEN(b.x)], 1u);
            asm volatile("s_waitcnt vmcnt(0)" ::: "memory");
        } else {
            XB_SPIN(xb_ld(&bar[XB_XGEN(b.x)]) == gen, bar);
            __builtin_amdgcn_fence(__ATOMIC_ACQUIRE, "agent");
            asm volatile("s_waitcnt vmcnt(0)" ::: "memory");
        }
    }
    __syncthreads();
}


constexpr int NPHASE = 46;
__device__ void run_phase(const Params& p, int ph, unsigned char* lds) {
    if (ph == 0) { phase_prologue(p, lds); return; }
    if (ph == NPHASE - 1) { phase_norm(p, 0, 3); return; }
    const int l = (ph - 1) / 11, s = (ph - 1) % 11;
    switch (s) {
        case 0: phase_norm(p, l, 0); break;
        case 1: phase_gemm<G_UP>(p, l, 0, lds); break;
        case 2: phase_gemm<G_DOWN>(p, l, 0, lds); break;
        case 3: phase_norm(p, l, 1); break;
        case 4: phase_gemm<G_WIN>(p, l, 0, lds); break;
        case 5: phase_mix(p, l, lds); break;
        case 6: phase_gemm<G_BR>(p, l, 0, lds); break;
        case 7: phase_gemm<G_OUT>(p, l, 0, lds); break;
        case 8: phase_norm(p, l, 2); break;
        case 9: phase_gemm<G_UP>(p, l, 1, lds); break;
        default: phase_gemm<G_DOWN>(p, l, 1, lds); break;
    }
}

__global__ void __launch_bounds__(NTHR, 2) fwd_kernel(Params p) {
    extern __shared__ __attribute__((aligned(16))) unsigned char lds[];
#if COOP
    cg::grid_group grid = cg::this_grid();
    volatile LAS unsigned* st = (volatile LAS unsigned*)(lds + LDS_X + 512);
    if (threadIdx.x == 0) { st[0] = 0u; st[1] = 0u; st[2] = 0u; st[3] = 0u; }
    __syncthreads();
    XcdBarrier xb = xcd_barrier_post((unsigned*)(p.ws + O_BAR), st);
    for (int ph = p.ph_lo; ph < p.ph_hi; ++ph) {
#ifdef PROBE_DUP
        { const int s_ = (ph == 0) ? 16 : (ph == NPHASE - 1 ? 17 : (ph - 1) % 11);
          const int nrep = ((PROBE_DUP >> s_) & 1) ? 2 : 1;
          for (int rep = 0; rep < nrep; ++rep) { if (rep) xcd_barrier(xb); run_phase(p, ph, lds); }
          if ((PROBE_DUP >> 20) & 1) { xcd_barrier(xb); } }
#else
        run_phase(p, ph, lds);
#endif
        if (ph + 1 < p.ph_hi) { if (p.ph_lo < 0) grid.sync(); else xcd_barrier(xb); }
    }
#else
    for (int ph = p.ph_lo; ph < p.ph_hi; ++ph) run_phase(p, ph, lds);
#endif
}

extern "C" void kernel_launch(void* const* d_in, const int* in_sizes, int n_in, void* d_out, int out_size, void* d_ws, size_t ws_size, hipStream_t stream) {
    static int grid_blocks = 0;
    if (!grid_blocks) {
        int dev = 0, cus = 0, per_cu = 0;
        hipGetDevice(&dev);
        hipDeviceGetAttribute(&cus, hipDeviceAttributeMultiprocessorCount, dev);
        hipFuncSetAttribute((const void*)fwd_kernel, hipFuncAttributeMaxDynamicSharedMemorySize, LDS_BYTES);
        hipOccupancyMaxActiveBlocksPerMultiprocessor(&per_cu, (const void*)fwd_kernel, NTHR, LDS_BYTES);
        if (per_cu < 1) per_cu = 1;
        if (per_cu > 1) per_cu = 1;
        grid_blocks = cus * per_cu;
        if (n_in != 23 || ws_size < WS_END) fprintf(stderr, "kernel_launch: unexpected n_in %d or ws_size %zu (need %zu)\n", n_in, ws_size, (size_t)WS_END);
    }
    Params p{};
    for (int i = 0; i < 23; ++i) p.in[i] = (const float*)d_in[i];
    p.out = (float*)d_out; p.ws = (unsigned char*)d_ws;
#if COOP
    p.ph_lo = 0; p.ph_hi = NPHASE;
    (void)hipMemsetAsync((unsigned char*)d_ws + O_BAR, 0, 16384, stream);
    void* args[] = {&p};
    hipError_t e = hipLaunchCooperativeKernel((const void*)fwd_kernel, dim3(grid_blocks), dim3(NTHR), args, LDS_BYTES, stream);
    if (e != hipSuccess) fprintf(stderr, "cooperative launch failed: %s (grid %d)\n", hipGetErrorString(e), grid_blocks);
#else
    for (int ph = 0; ph < NPHASE; ++ph) {
        p.ph_lo = ph; p.ph_hi = ph + 1;
        hipLaunchKernelGGL(fwd_kernel, dim3(grid_blocks), dim3(NTHR), LDS_BYTES, stream, p);
    }
#endif
}
```

```cpp
#include <hip/hip_runtime.h>
#include <hip/hip_cooperative_groups.h>
#include <cstdio>
#include <cstdint>
namespace cg = cooperative_groups;

#ifndef COOP
#define COOP 1
#endif

typedef unsigned short bf16_t;
typedef short bf16x8 __attribute__((ext_vector_type(8)));
typedef short s16x4 __attribute__((ext_vector_type(4)));
typedef float f32x4 __attribute__((ext_vector_type(4)));
typedef float f32x2 __attribute__((ext_vector_type(2)));
typedef __bf16 bf16x2_t __attribute__((ext_vector_type(2)));
typedef unsigned u32x2 __attribute__((ext_vector_type(2)));
typedef unsigned u32x4 __attribute__((ext_vector_type(4)));

#define DI __device__ __forceinline__

constexpr int R = 6144;
constexpr int RC = 4096;
constexpr int D = 1024;
constexpr int DFF = 2816;
constexpr int INW = 7168;
constexpr int NTHR = 512;
constexpr int LDS_X = 147456;
constexpr int LDS_BYTES = LDS_X + 1024;
constexpr float EPS = 1e-6f;

constexpr size_t al(size_t x) { return (x + 255) & ~(size_t)255; }
constexpr size_t O_X = 0;
constexpr size_t O_H = al(O_X + (size_t)R * D * 4);
constexpr size_t O_ACT = al(O_H + (size_t)R * D * 2);
constexpr size_t O_U = al(O_ACT + (size_t)R * DFF * 2);
constexpr size_t O_VT = al(O_U + (size_t)R * D * 2);
constexpr size_t O_VSS = al(O_VT + (size_t)R * D * 2);
constexpr size_t O_Q = al(O_VSS + (size_t)R * 16 * 4);
constexpr size_t O_KC = al(O_Q + (size_t)R * D * 2);
constexpr size_t O_KL = al(O_KC + (size_t)RC * D * 2);
constexpr size_t O_VTC = al(O_KL + (size_t)8 * 1280 * D * 2);
constexpr size_t O_VTL = al(O_VTC + (size_t)16 * 8 * 128 * 256 * 2);
constexpr size_t O_SG = al(O_VTL + (size_t)8 * 8 * 128 * 1280 * 2);
constexpr size_t O_ABR = al(O_SG + (size_t)R * 2048 * 2);
constexpr size_t O_BBR = al(O_ABR + (size_t)R * D * 2);
constexpr size_t O_MG = al(O_BBR + (size_t)R * D * 2);
constexpr size_t O_MG1 = al(O_MG + (size_t)R * D * 2);
constexpr size_t O_MOD = al(O_MG1 + (size_t)R * D * 4);
constexpr size_t O_ROPE = al(O_MOD + (size_t)4 * 3 * 9216 * 4);
constexpr size_t O_W = al(O_ROPE + 8192);
constexpr size_t WE_13A = 0;
constexpr size_t WE_2A = WE_13A + (size_t)5632 * 1024;
constexpr size_t WE_IN = WE_2A + (size_t)1024 * 2816;
constexpr size_t WE_A = WE_IN + (size_t)7168 * 1024;
constexpr size_t WE_B = WE_A + (size_t)1024 * 1024;
constexpr size_t WE_O = WE_B + (size_t)1024 * 1024;
constexpr size_t WE_13B = WE_O + (size_t)1024 * 1024;
constexpr size_t WE_2B = WE_13B + (size_t)5632 * 1024;
constexpr size_t WE_LAYER = WE_2B + (size_t)1024 * 2816;
constexpr size_t O_BAR = al(O_W + WE_LAYER * 4 * 2);
constexpr size_t WS_END = O_BAR + 16384;

struct Params {
    const float* in[23];
    float* out;
    unsigned char* ws;
    int ph_lo, ph_hi;
};

DI unsigned pk(float a, float b) { f32x2 v = {a, b}; bf16x2_t r = __builtin_convertvector(v, bf16x2_t); return __builtin_bit_cast(unsigned, r); }
DI float bf2f(bf16_t v) { return __uint_as_float(((unsigned)v) << 16); }
DI float bfround(float a) { unsigned u = pk(a, 0.f); return __uint_as_float(u << 16); }
DI float fexp2(float x) { return __builtin_amdgcn_exp2f(x); }
DI float fexp(float x) { return __builtin_amdgcn_exp2f(x * 1.44269504089f); }
DI float frcp(float x) { return __builtin_amdgcn_rcpf(x); }
DI float sigmoidf_(float x) { return frcp(1.f + fexp(-x)); }
DI float siluf_(float x) { return x * sigmoidf_(x); }
DI float geluf_(float x) { float u = 0.7978845608f * (x + 0.044715f * x * x * x); return x * frcp(1.f + fexp(-2.f * u)); }
DI int otid() { int t = threadIdx.x; asm volatile("" : "+v"(t)); return t; }
DI int cond_of_row(int row) { return row < RC ? 0 : 1 + ((row - RC) >> 10); }

DI int lds_byte(int r, int c) { const int st = (r >> 4) * 2 + (c >> 5), rr = r & 15, cc = c & 31, ob = rr * 64 + cc * 2; return st * 1024 + (ob ^ (((ob >> 9) & 1) << 5)); }
DI void stage_rc(int b, int& Rr, int& Cc) { const int st = b / 1024, sb = b % 1024, swz = sb ^ (((sb >> 9) & 1) << 5); Rr = (st >> 1) * 16 + swz / 64; Cc = (st & 1) * 32 + (swz % 64) / 2; }

DI void glds16(const void* g, void* l) { __builtin_amdgcn_global_load_lds((const unsigned*)g, (unsigned*)l, 16, 0, 0); }
#define WAIT_VM0() asm volatile("s_waitcnt vmcnt(0)" ::: "memory")

template <int NI = 4>
DI void stage_half(unsigned char* buf, const bf16_t* src, int ld, int tid) {
#pragma unroll
    for (int i = 0; i < NI; ++i) {
        const int b = tid * 16 + i * 8192; int r, c; stage_rc(b, r, c);
        glds16(src + (size_t)r * ld + c, buf + b);
    }
}

#define LDS_RD(dst, base, off) asm volatile("ds_read_b128 %0, %1 offset:" #off : "=v"(dst) : "v"(base) : "memory")
template <int MI>
DI void compute_ktile(unsigned sa, unsigned sb, f32x4 (&acc)[MI][4]) {
    bf16x8 af[2][4], bw[2][4];
    LDS_RD(af[0][0], sa, 0); if (MI > 1) LDS_RD(af[0][1], sa, 2048); if (MI > 2) LDS_RD(af[0][2], sa, 4096); if (MI > 3) LDS_RD(af[0][3], sa, 6144);
    LDS_RD(bw[0][0], sb, 0); LDS_RD(bw[0][1], sb, 2048); LDS_RD(bw[0][2], sb, 4096); LDS_RD(bw[0][3], sb, 6144);
    LDS_RD(af[1][0], sa, 1024); if (MI > 1) LDS_RD(af[1][1], sa, 3072); if (MI > 2) LDS_RD(af[1][2], sa, 5120); if (MI > 3) LDS_RD(af[1][3], sa, 7168);
    LDS_RD(bw[1][0], sb, 1024); LDS_RD(bw[1][1], sb, 3072); LDS_RD(bw[1][2], sb, 5120); LDS_RD(bw[1][3], sb, 7168);
    __builtin_amdgcn_sched_barrier(0);
    if (MI == 4) asm volatile("s_waitcnt lgkmcnt(8)" ::: "memory"); else if (MI == 3) asm volatile("s_waitcnt lgkmcnt(7)" ::: "memory"); else if (MI == 2) asm volatile("s_waitcnt lgkmcnt(6)" ::: "memory"); else asm volatile("s_waitcnt lgkmcnt(5)" ::: "memory");
    __builtin_amdgcn_sched_barrier(0);
#pragma unroll
    for (int m = 0; m < MI; ++m)
#pragma unroll
        for (int n = 0; n < 4; ++n) acc[m][n] = __builtin_amdgcn_mfma_f32_16x16x32_bf16(bw[0][n], af[0][m], acc[m][n], 0, 0, 0);
    __builtin_amdgcn_sched_barrier(0);
    asm volatile("s_waitcnt lgkmcnt(0)" ::: "memory");
    __builtin_amdgcn_sched_barrier(0);
#pragma unroll
    for (int m = 0; m < MI; ++m)
#pragma unroll
        for (int n = 0; n < 4; ++n) acc[m][n] = __builtin_amdgcn_mfma_f32_16x16x32_bf16(bw[1][n], af[1][m], acc[m][n], 0, 0, 0);
    __builtin_amdgcn_sched_barrier(0);
}
DI unsigned lds_addr(const void* p) { return (unsigned)(uintptr_t)(const __attribute__((address_space(3))) unsigned char*)p; }

template <int MI>
DI void gemm_tile(const bf16_t* A, int lda, const bf16_t* Bt, int ldb, int K, int m0, int n0, f32x4 (&acc)[MI][4], unsigned char* lds) {
    const int tid = otid(), wid = tid >> 6, lane = tid & 63, wr = wid >> 1, wc = wid & 1, fr = lane & 15, fq = lane >> 4;
#pragma unroll
    for (int m = 0; m < MI; ++m)
#pragma unroll
        for (int n = 0; n < 4; ++n) acc[m][n] = (f32x4){0.f, 0.f, 0.f, 0.f};
    const bf16_t* Ab = A + (size_t)m0 * lda;
    const bf16_t* Bb = Bt + (size_t)n0 * ldb;
    const int nt = K >> 6;
    const unsigned la = lds_addr(lds) + lds_byte(wr * (MI * 16) + fr, fq * 8), lb = lds_addr(lds) + 32768 + lds_byte(wc * 64 + fr, fq * 8);
    __syncthreads();
    stage_half<MI>(lds, Ab, lda, tid);
    stage_half<2>(lds + 32768, Bb, ldb, tid);
    stage_half<MI>(lds + 49152, Ab + 64, lda, tid);
    stage_half<2>(lds + 49152 + 32768, Bb + 64, ldb, tid);
    int cur = 0, nxt = 2;
    for (int t = 0; t < nt; ++t) {
        if (t + 1 < nt) { if (MI == 4) asm volatile("s_waitcnt vmcnt(6)" ::: "memory"); else if (MI == 3) asm volatile("s_waitcnt vmcnt(5)" ::: "memory"); else if (MI == 2) asm volatile("s_waitcnt vmcnt(4)" ::: "memory"); else asm volatile("s_waitcnt vmcnt(3)" ::: "memory"); }
        else asm volatile("s_waitcnt vmcnt(0)" ::: "memory");
        __builtin_amdgcn_sched_barrier(0);
        asm volatile("" ::: "memory");
        __builtin_amdgcn_s_barrier();
        asm volatile("" ::: "memory");
        __builtin_amdgcn_sched_barrier(0);
        if (t + 2 < nt) {
            stage_half<MI>(lds + nxt * 49152, Ab + (t + 2) * 64, lda, tid);
            stage_half<2>(lds + nxt * 49152 + 32768, Bb + (t + 2) * 64, ldb, tid);
        }
        compute_ktile<MI>(la + cur * 49152, lb + cur * 49152, acc);
        cur = (cur == 2) ? 0 : cur + 1; nxt = (nxt == 2) ? 0 : nxt + 1;
    }
}

DI void store_bf4(bf16_t* p, f32x4 v) { u32x2 w; w.x = pk(v[0], v[1]); w.y = pk(v[2], v[3]); *(u32x2*)p = w; }

DI void transpose_tile(const float* __restrict__ src, int ld_src, bf16_t* __restrict__ dst, int ld_dst, int k0, int r0, int perm, float* tile_base) {
    const int tid = otid(), lt = tid & 255;
    float* tile = tile_base + (tid >> 8) * (64 * 65);
    const int ty = lt >> 4, tx = lt & 15, nn = tx * 4;
    const int scol = perm ? ((nn >> 5) * DFF + (r0 >> 7) * 64 + ((r0 >> 6) & 1) * 32 + (nn & 31)) : (r0 + nn);
    __syncthreads();
#pragma unroll
    for (int i = 0; i < 4; ++i) {
        const int kk = ty + 16 * i;
        const f32x4 v = __builtin_nontemporal_load((const f32x4*)(src + (size_t)(k0 + kk) * ld_src + scol));
        tile[kk * 65 + nn + 0] = v[0]; tile[kk * 65 + nn + 1] = v[1]; tile[kk * 65 + nn + 2] = v[2]; tile[kk * 65 + nn + 3] = v[3];
    }
    __syncthreads();
    const int n = lt >> 2, kc = lt & 3;
    u32x4 w0, w1;
    w0.x = pk(tile[(kc * 16 + 0) * 65 + n], tile[(kc * 16 + 1) * 65 + n]);
    w0.y = pk(tile[(kc * 16 + 2) * 65 + n], tile[(kc * 16 + 3) * 65 + n]);
    w0.z = pk(tile[(kc * 16 + 4) * 65 + n], tile[(kc * 16 + 5) * 65 + n]);
    w0.w = pk(tile[(kc * 16 + 6) * 65 + n], tile[(kc * 16 + 7) * 65 + n]);
    w1.x = pk(tile[(kc * 16 + 8) * 65 + n], tile[(kc * 16 + 9) * 65 + n]);
    w1.y = pk(tile[(kc * 16 + 10) * 65 + n], tile[(kc * 16 + 11) * 65 + n]);
    w1.z = pk(tile[(kc * 16 + 12) * 65 + n], tile[(kc * 16 + 13) * 65 + n]);
    w1.w = pk(tile[(kc * 16 + 14) * 65 + n], tile[(kc * 16 + 15) * 65 + n]);
    u32x4* d = (u32x4*)(dst + (size_t)(r0 + n) * ld_dst + k0 + kc * 16);
    d[0] = w0; d[1] = w1;
}

__device__ void phase_prologue(const Params& p, unsigned char* lds) {
    const int tid = otid();
    float* tile = (float*)lds;
    bf16_t* W = (bf16_t*)(p.ws + O_W);
    constexpr int NT_W = 27136 / 2, NT_MOD = 576, NT_CK = 512, NT_CV = 512 / 2, NT_X = 768;
    constexpr int TOTAL = NT_W + NT_MOD + NT_CK + NT_CV + NT_X + 1;
    for (int it = blockIdx.x; it < TOTAL; it += gridDim.x) {
        if (it < NT_W) {
            const int it2 = it * 2 + (tid >> 8);
            const int l = it2 / 6784, r = it2 % 6784;
            int widx, ti;
            if (r < 1408) { widx = 0; ti = r; } else if (r < 2112) { widx = 1; ti = r - 1408; } else if (r < 3904) { widx = 2; ti = r - 2112; }
            else if (r < 4160) { widx = 3; ti = r - 3904; } else if (r < 4416) { widx = 4; ti = r - 4160; } else if (r < 4672) { widx = 5; ti = r - 4416; }
            else if (r < 6080) { widx = 6; ti = r - 4672; } else { widx = 7; ti = r - 6080; }
            const float* src; int K, N, perm = 0; size_t we;
            switch (widx) {
                case 0: src = p.in[9]; K = 1024; N = 5632; perm = 1; we = WE_13A; break;
                case 1: src = p.in[10]; K = 2816; N = 1024; we = WE_2A; break;
                case 2: src = p.in[11]; K = 1024; N = 7168; we = WE_IN; break;
                case 3: src = p.in[17]; K = 1024; N = 1024; we = WE_A; break;
                case 4: src = p.in[18]; K = 1024; N = 1024; we = WE_B; break;
                case 5: src = p.in[19]; K = 1024; N = 1024; we = WE_O; break;
                case 6: src = p.in[20]; K = 1024; N = 5632; perm = 1; we = WE_13B; break;
                default: src = p.in[21]; K = 2816; N = 1024; we = WE_2B; break;
            }
            const int nkt = K >> 6;
            const int nrt = N >> 6;
            const int rt = ti % nrt, kt = ti / nrt;
            transpose_tile(src + (size_t)l * K * N, N, W + (size_t)l * WE_LAYER + we, K, kt * 64, rt * 64, perm, tile);
        } else if (it < NT_W + NT_MOD) {
            const int j = it - NT_W, l = j / 144, cb = j % 144;
            const int tx = tid & 15, kg = tid >> 4;
            const float* wm = p.in[6] + (size_t)l * 1024 * 9216 + cb * 64 + tx * 4;
            f32x4 a0 = {0.f, 0.f, 0.f, 0.f}, a1 = a0, a2 = a0;
#pragma unroll 8
            for (int k = kg; k < 1024; k += 32) {
                const f32x4 w = __builtin_nontemporal_load((const f32x4*)(wm + (size_t)k * 9216));
                const float s0 = siluf_(p.in[5][k]), s1 = siluf_(p.in[4][k]), s2 = siluf_(p.in[4][1024 + k]);
                a0 += w * s0; a1 += w * s1; a2 += w * s2;
            }
            __syncthreads();
            float* red = tile;
#pragma unroll
            for (int q = 0; q < 4; ++q) { red[(kg * 3 + 0) * 64 + tx * 4 + q] = a0[q]; red[(kg * 3 + 1) * 64 + tx * 4 + q] = a1[q]; red[(kg * 3 + 2) * 64 + tx * 4 + q] = a2[q]; }
            __syncthreads();
            if (tid < 192) {
                const int c = tid >> 6, col = tid & 63;
                float s = 0.f;
#pragma unroll
                for (int g = 0; g < 32; ++g) s += red[(g * 3 + c) * 64 + col];
                const int jc = cb * 64 + col;
                ((float*)(p.ws + O_MOD))[(size_t)(l * 3 + c) * 9216 + jc] = s + p.in[7][l * 9216 + jc];
            }
        } else if (it < NT_W + NT_MOD + NT_CK) {
            const int j = it - NT_W - NT_MOD;
            const size_t e0 = (size_t)j * 4096 + tid * 8;
            const int col = (int)(e0 & 1023), key = (int)((e0 >> 10) & 255), bl = (int)(e0 >> 18), b = bl >> 2, l = bl & 3;
            const f32x4 v0 = __builtin_nontemporal_load((const f32x4*)(p.in[2] + e0)), v1 = __builtin_nontemporal_load((const f32x4*)(p.in[2] + e0 + 4));
            u32x4 w; w.x = pk(v0[0], v0[1]); w.y = pk(v0[2], v0[3]); w.z = pk(v1[0], v1[1]); w.w = pk(v1[2], v1[3]);
            *(u32x4*)((bf16_t*)(p.ws + O_KL) + ((size_t)(l * 2 + b) * 1280 + key) * 1024 + col) = w;
        } else if (it < NT_W + NT_MOD + NT_CK + NT_CV) {
            const int j = (it - NT_W - NT_MOD - NT_CK) * 2 + (tid >> 8);
            const int et = j & 1, kt = (j >> 1) & 3, h = (j >> 3) & 7, l = (j >> 6) & 3, b = j >> 8;
            const float* src = p.in[3] + ((size_t)(b * 4 + l) * 256) * 1024 + h * 128;
            bf16_t* dst = (bf16_t*)(p.ws + O_VTL) + ((size_t)((l * 2 + b) * 8 + h) * 128) * 1280;
            transpose_tile(src, 1024, dst, 1280, kt * 64, et * 64, 0, tile);
        } else if (it == TOTAL - 1) {
            float* RT = (float*)(p.ws + O_ROPE);
#pragma unroll
            for (int i = 0; i < 2; ++i) {
                const int e = tid + i * 512, pos = e >> 4, fi = e & 15;
                const float ang = (float)pos * fexp2(-(float)fi * 0.8304820237f);
                float rev = ang * 0.15915494309f; rev -= floorf(rev);
                RT[e] = __builtin_amdgcn_cosf(rev); RT[1024 + e] = __builtin_amdgcn_sinf(rev);
            }
        } else {
            const int j = it - NT_W - NT_MOD - NT_CK - NT_CV;
            float* X = (float*)(p.ws + O_X);
#pragma unroll
            for (int i = 0; i < 4; ++i) {
                const size_t e = (size_t)j * 8192 + i * 2048 + tid * 4;
                const f32x4 v = (e < (size_t)RC * D) ? *(const f32x4*)(p.in[0] + e) : *(const f32x4*)(p.in[1] + (e - (size_t)RC * D));
                *(f32x4*)(X + e) = v;
            }
        }
    }
}

__device__ void phase_norm(const Params& p, int l, int which) {
    const int tid_ = otid(); const int lane = tid_ & 63, wid = tid_ >> 6;
    const float* X = (const float*)(p.ws + O_X);
    const float* MOD = (const float*)(p.ws + O_MOD);
    bf16_t* H = (bf16_t*)(p.ws + O_H);
    const int gw = blockIdx.x * 8 + wid, nw = gridDim.x * 8;
    for (int row0 = gw; row0 < R; row0 += 3 * nw) {
        f32x4 v[3][4];
#pragma unroll
        for (int j = 0; j < 3; ++j) {
            const int row = row0 + j * nw;
            if (row < R) {
#pragma unroll
                for (int i = 0; i < 4; ++i) v[j][i] = *(const f32x4*)(X + (size_t)row * D + i * 256 + lane * 4);
            }
        }
#pragma unroll
        for (int j = 0; j < 3; ++j) {
            const int row = row0 + j * nw;
            if (row < R) {
                float ss = 0.f;
#pragma unroll
                for (int i = 0; i < 4; ++i) ss += v[j][i][0] * v[j][i][0] + v[j][i][1] * v[j][i][1] + v[j][i][2] * v[j][i][2] + v[j][i][3] * v[j][i][3];
#pragma unroll
                for (int o = 32; o >= 1; o >>= 1) ss += __shfl_xor(ss, o);
                const float r = __builtin_amdgcn_rsqf(ss * (1.f / 1024.f) + EPS);
                if (which < 3) {
                    const float* g = p.in[8] + (size_t)(l * 3 + which) * D;
                    const float* md = MOD + (size_t)(l * 3 + cond_of_row(row)) * 9216 + (size_t)(3 * which) * D;
#pragma unroll
                    for (int i = 0; i < 4; ++i) {
                        const int c = i * 256 + lane * 4;
                        const f32x4 gg = *(const f32x4*)(g + c), sh = *(const f32x4*)(md + c), sc = *(const f32x4*)(md + D + c);
                        store_bf4(H + (size_t)row * D + c, (v[j][i] * r) * gg * (sc + 1.f) + sh);
                    }
                } else {
#pragma unroll
                    for (int i = 0; i < 4; ++i) {
                        const int c = i * 256 + lane * 4;
                        *(f32x4*)(p.out + (size_t)row * D + c) = (v[j][i] * r) * (*(const f32x4*)(p.in[22] + c));
                    }
                }
            }
        }
    }
}

enum { G_UP = 0, G_DOWN = 1, G_WIN = 2, G_BR = 3, G_OUT = 4 };

template <int KIND, int MI>
DI void gemm_item(const Params& p, int l, int second, int m0, int ntile, unsigned char* lds) {
    const int tid = otid(), wid = tid >> 6, lane = tid & 63, wr = wid >> 1, wc = wid & 1, fr = lane & 15, fq = lane >> 4;
    const bf16_t* W = (const bf16_t*)(p.ws + O_W) + (size_t)l * WE_LAYER;
    const float* MOD = (const float*)(p.ws + O_MOD);
    float* X = (float*)(p.ws + O_X);
    const bf16_t* H = (const bf16_t*)(p.ws + O_H);
    bf16_t* ACT = (bf16_t*)(p.ws + O_ACT);
    constexpr int WMR = MI * 16;
    const int n0 = ntile * 128;
    {
        f32x4 acc[MI][4];
        if (KIND == G_UP) {
            gemm_tile<MI>(H, D, W + (second ? WE_13B : WE_13A), D, D, m0, n0, acc, lds);
#pragma unroll
            for (int m = 0; m < MI; ++m) {
                const int row = m0 + wr * WMR + m * 16 + fr;
#pragma unroll
                for (int nn = 0; nn < 2; ++nn) {
                    f32x4 o;
#pragma unroll
                    for (int j = 0; j < 4; ++j) o[j] = siluf_(acc[m][nn][j]) * acc[m][nn + 2][j];
                    store_bf4(ACT + (size_t)row * DFF + ntile * 64 + wc * 32 + nn * 16 + fq * 4, o);
                }
            }
        } else if (KIND == G_DOWN || KIND == G_OUT) {
            if (KIND == G_DOWN) gemm_tile<MI>(ACT, DFF, W + (second ? WE_2B : WE_2A), DFF, DFF, m0, n0, acc, lds);
            else gemm_tile<MI>((const bf16_t*)(p.ws + O_MG), D, W + WE_O, D, D, m0, n0, acc, lds);
            const int slot = (KIND == G_OUT) ? 5 : (second ? 8 : 2);
            const float scl = (KIND == G_OUT) ? 1.f : 0.5f;
#pragma unroll
            for (int m = 0; m < MI; ++m) {
                const int row = m0 + wr * WMR + m * 16 + fr;
                const float* gt = MOD + (size_t)(l * 3 + cond_of_row(row)) * 9216 + (size_t)slot * D;
#pragma unroll
                for (int n = 0; n < 4; ++n) {
                    const int col = n0 + wc * 64 + n * 16 + fq * 4;
                    const f32x4 g = *(const f32x4*)(gt + col) * scl;
                    f32x4* xp = (f32x4*)(X + (size_t)row * D + col);
                    *xp = *xp + g * acc[m][n];
                }
            }
        } else if (KIND == G_BR) {
            const bf16_t* SG = (const bf16_t*)(p.ws + O_SG);
            gemm_tile<MI>((const bf16_t*)(p.ws + O_ABR), D, W + WE_A, D, D, m0, n0, acc, lds);
            float* MG1 = (float*)(p.ws + O_MG1);
#pragma unroll
            for (int m = 0; m < MI; ++m) {
                const int row = m0 + wr * WMR + m * 16 + fr;
#pragma unroll
                for (int n = 0; n < 4; ++n) {
                    const int col = n0 + wc * 64 + n * 16 + fq * 4;
                    const u32x2 gv = *(const u32x2*)(SG + (size_t)row * 2048 + col);
                    f32x4 g; g[0] = __uint_as_float(gv.x << 16); g[1] = __uint_as_float(gv.x & 0xffff0000u); g[2] = __uint_as_float(gv.y << 16); g[3] = __uint_as_float(gv.y & 0xffff0000u);
                    *(f32x4*)(MG1 + (size_t)row * D + col) = g * acc[m][n];
                }
            }
            gemm_tile<MI>((const bf16_t*)(p.ws + O_BBR), D, W + WE_B, D, D, m0, n0, acc, lds);
            bf16_t* MG = (bf16_t*)(p.ws + O_MG);
#pragma unroll
            for (int m = 0; m < MI; ++m) {
                const int row = m0 + wr * WMR + m * 16 + fr;
#pragma unroll
                for (int n = 0; n < 4; ++n) {
                    const int col = n0 + wc * 64 + n * 16 + fq * 4;
                    const u32x2 gv = *(const u32x2*)(SG + (size_t)row * 2048 + 1024 + col);
                    f32x4 g; g[0] = __uint_as_float(gv.x << 16); g[1] = __uint_as_float(gv.x & 0xffff0000u); g[2] = __uint_as_float(gv.y << 16); g[3] = __uint_as_float(gv.y & 0xffff0000u);
                    const f32x4 m1 = *(const f32x4*)(MG1 + (size_t)row * D + col);
                    store_bf4(MG + (size_t)row * D + col, m1 + g * acc[m][n]);
                }
            }
        } else {
            gemm_tile<MI>(H, D, W + WE_IN, D, D, m0, n0, acc, lds);
            const bool ctx = m0 < RC;
            const int b = ctx ? (m0 >> 8) : ((m0 - RC) >> 10);
            const int pos0 = (ctx ? (m0 & 255) : ((m0 - RC) & 1023)) + wr * WMR;
            if (n0 < 1024) {
                bf16_t* U = (bf16_t*)(p.ws + O_U);
#pragma unroll
                for (int m = 0; m < MI; ++m)
#pragma unroll
                    for (int n = 0; n < 4; ++n) {
                        f32x4 o;
#pragma unroll
                        for (int j = 0; j < 4; ++j) o[j] = geluf_(acc[m][n][j]);
                        store_bf4(U + (size_t)(m0 + wr * WMR + m * 16 + fr) * D + n0 + wc * 64 + n * 16 + fq * 4, o);
                    }
            } else if (n0 < 2048) {
                bf16_t* VT = (bf16_t*)(p.ws + O_VT);
                float* VSS = (float*)(p.ws + O_VSS);
#pragma unroll
                for (int m = 0; m < MI; ++m) {
                    const int row = m0 + wr * WMR + m * 16 + fr;
                    float ss = 0.f;
#pragma unroll
                    for (int n = 0; n < 4; ++n)
#pragma unroll
                        for (int j = 0; j < 4; ++j) {
                            const float gq = bfround(geluf_(acc[m][n][j]));
                            ss += gq * gq;
                            const int ch = n0 - 1024 + wc * 64 + n * 16 + fq * 4 + j;
                            VT[(size_t)ch * R + row] = (bf16_t)(__float_as_uint(gq) >> 16);
                        }
                    ss += __shfl_xor(ss, 16); ss += __shfl_xor(ss, 32);
                    if (fq == 0) VSS[(size_t)row * 16 + ((n0 - 1024) >> 7) * 2 + wc] = ss;
                }
            } else if (n0 < 4096) {
                const bool isq = n0 < 3072;
                const int cb = (isq ? n0 - 2048 : n0 - 3072) + wc * 64;
                if (!isq && ctx) {
                    float* ok = p.out + (size_t)R * D + ((size_t)(b * 4 + l) * 256) * 1024;
#pragma unroll
                    for (int m = 0; m < MI; ++m) {
#pragma unroll
                        for (int n = 0; n < 4; ++n) __builtin_nontemporal_store(acc[m][n], (f32x4*)(ok + (size_t)(pos0 + m * 16 + fr) * 1024 + cb + n * 16 + fq * 4));
                        __builtin_amdgcn_sched_barrier(0);
                    }
                    __builtin_amdgcn_sched_barrier(0);
                }
                if (!ctx) {
                    const float* RC_ = (const float*)(p.ws + O_ROPE);
                    const f32x4 cr = *(const f32x4*)(RC_ + (pos0 >> 6) * 16 + fq * 4), sr = *(const f32x4*)(RC_ + 1024 + (pos0 >> 6) * 16 + fq * 4);
#pragma unroll
                    for (int m = 0; m < MI; ++m) {
                        const int gc = (pos0 & 63) + m * 16 + fr;
                        const f32x4 cc = *(const f32x4*)(RC_ + gc * 16 + fq * 4), sc = *(const f32x4*)(RC_ + 1024 + gc * 16 + fq * 4);
                        const f32x4 x1 = acc[m][0], x2 = acc[m][1], y1 = acc[m][2], y2 = acc[m][3];
                        acc[m][0] = x1 * cr - x2 * sr; acc[m][1] = x2 * cr + x1 * sr;
                        acc[m][2] = y1 * cc - y2 * sc; acc[m][3] = y2 * cc + y1 * sc;
                    }
                }
                bf16_t* dst; size_t rowbase;
                if (isq) { dst = (bf16_t*)(p.ws + O_Q); rowbase = (size_t)(m0 + wr * WMR); }
                else if (ctx) { dst = (bf16_t*)(p.ws + O_KC); rowbase = (size_t)(m0 + wr * WMR); }
                else { dst = (bf16_t*)(p.ws + O_KL); rowbase = (size_t)(l * 2 + b) * 1280 + 256 + pos0; }
                const float qs = isq ? 0.18033688011f : 1.f;
#pragma unroll
                for (int m = 0; m < MI; ++m) {
#pragma unroll
                    for (int n = 0; n < 4; ++n) store_bf4(dst + (rowbase + m * 16 + fr) * 1024 + cb + n * 16 + fq * 4, acc[m][n] * qs);
                    __builtin_amdgcn_sched_barrier(0);
                }
            } else if (n0 < 5120) {
                const int h = (n0 - 4096) >> 7;
                if (ctx) {
                    float* ov = p.out + (size_t)R * D + (size_t)16 * 4 * 256 * 1024 + ((size_t)(b * 4 + l) * 256) * 1024;
#pragma unroll
                    for (int m = 0; m < MI; ++m)
#pragma unroll
                        for (int n = 0; n < 4; ++n) __builtin_nontemporal_store(acc[m][n], (f32x4*)(ov + (size_t)(pos0 + m * 16 + fr) * 1024 + (n0 - 4096) + wc * 64 + n * 16 + fq * 4));
                }
                bf16_t* vt; int ldv, koff;
                if (ctx) { vt = (bf16_t*)(p.ws + O_VTC) + ((size_t)(b * 8 + h) * 128) * 256; ldv = 256; koff = pos0; }
                else { vt = (bf16_t*)(p.ws + O_VTL) + ((size_t)((l * 2 + b) * 8 + h) * 128) * 1280; ldv = 1280; koff = 256 + pos0; }
#pragma unroll
                for (int m = 0; m < MI; ++m)
#pragma unroll
                    for (int n = 0; n < 4; ++n)
#pragma unroll
                        for (int j = 0; j < 4; ++j) {
                            const int e = wc * 64 + n * 16 + fq * 4 + j;
                            vt[(size_t)e * ldv + koff + m * 16 + fr] = (bf16_t)(pk(acc[m][n][j], 0.f) & 0xffffu);
                            if (j == 3) __builtin_amdgcn_sched_barrier(0);
                        }
            } else {
                bf16_t* SG = (bf16_t*)(p.ws + O_SG);
#pragma unroll
                for (int m = 0; m < MI; ++m)
#pragma unroll
                    for (int n = 0; n < 4; ++n) {
                        f32x4 o;
#pragma unroll
                        for (int j = 0; j < 4; ++j) o[j] = sigmoidf_(acc[m][n][j]);
                        store_bf4(SG + (size_t)(m0 + wr * WMR + m * 16 + fr) * 2048 + (n0 - 5120) + wc * 64 + n * 16 + fq * 4, o);
                    }
            }
        }
    }
}

template <int KIND>
__device__ void phase_gemm(const Params& p, int l, int second, unsigned char* lds) {
    const int G = (int)gridDim.x, bid = (int)blockIdx.x;
    if (KIND == G_UP || KIND == G_WIN) {
        const int NTN = (KIND == G_UP) ? 44 : 56, ntiles = 24 * NTN;
        if (KIND == G_WIN && (G & 7) == 0) {
            const int x = bid & 7, lb = bid >> 3, nb = G >> 3, nloc = 24 * 7;
            const int nfull = (nloc / nb) * nb, nrem = nloc - nfull;
            auto ntile_of = [&](int ni) { return ni == 0 ? 16 + x : ni == 1 ? 24 + x : ni == 2 ? 32 + x : ni < 5 ? 2 * x + (ni - 3) : 40 + 2 * x + (ni - 5); };
            for (int j = lb; j < nfull; j += nb) gemm_item<KIND, 4>(p, l, second, (j / 7) * 256, ntile_of(j % 7), lds);
            for (int q = lb; q < nrem * 4; q += nb) { const int j = nfull + (q >> 2); gemm_item<KIND, 1>(p, l, second, (j / 7) * 256 + (q & 3) * 64, ntile_of(j % 7), lds); }
        } else if ((G & 7) == 0) {
            const int x = bid & 7, lb = bid >> 3, nb = G >> 3, mx = x & 3, nx = x >> 2, npx = NTN >> 1, nloc = 6 * npx;
            const int nfull = (nloc / nb) * nb, nrem = nloc - nfull;
            for (int j = lb; j < nfull; j += nb) gemm_item<KIND, 4>(p, l, second, (mx * 6 + j % 6) * 256, nx * npx + j / 6, lds);
            for (int q = lb; q < nrem * 4; q += nb) { const int j = nfull + (q >> 2); gemm_item<KIND, 1>(p, l, second, (mx * 6 + j % 6) * 256 + (q & 3) * 64, nx * npx + j / 6, lds); }
        } else {
            const int nfull = (ntiles / G) * G, nrem = ntiles - nfull;
            for (int t = bid; t < nfull; t += G) gemm_item<KIND, 4>(p, l, second, (t % 24) * 256, t / 24, lds);
            for (int j = bid; j < nrem * 4; j += G) { const int t = nfull + (j >> 2); gemm_item<KIND, 1>(p, l, second, (t % 24) * 256 + (j & 3) * 64, t / 24, lds); }
        }
    } else {
        for (int t = bid; t < 32 * 8; t += G) gemm_item<KIND, 3>(p, l, second, (t % 32) * 192, t / 32, lds);
    }
}

__device__ void spatial_item(const Params& p, int l, int item, unsigned char* lds) {
    const int tid = otid(), wid = tid >> 6, lane = tid & 63, wr = wid >> 2, wc = wid & 3, fr = lane & 15, fq = lane >> 4;
    const int g = item & 3, ck = item >> 2;
    const int m0 = ck * 128, c0 = g * 256;
    const bf16_t* VT = (const bf16_t*)(p.ws + O_VT);
    const float* VSS = (const float*)(p.ws + O_VSS);
    float* rstd = (float*)(lds + LDS_X);
    __syncthreads();
    if (tid < 128) {
        const f32x4* q = (const f32x4*)(VSS + (size_t)(m0 + tid) * 16);
        const f32x4 a = q[0] + q[1] + q[2] + q[3];
        rstd[tid] = __builtin_amdgcn_rsqf((a[0] + a[1] + a[2] + a[3]) * (1.f / 1024.f) + EPS);
    }
    stage_half<4>(lds + 32768, VT + (size_t)c0 * R + m0, R, tid);
    stage_half<4>(lds + 65536, VT + (size_t)c0 * R + m0 + 64, R, tid);
    __syncthreads();
    const float* ws = p.in[13] + (size_t)(l * 4 + g) * 128 * 128;
#pragma unroll
    for (int t = 0; t < 2; ++t)
#pragma unroll
        for (int i = 0; i < 2; ++i) {
            const int b = tid * 16 + i * 8192; int r, c; stage_rc(b, r, c);
            const f32x4 v0 = *(const f32x4*)(ws + r * 128 + t * 64 + c), v1 = *(const f32x4*)(ws + r * 128 + t * 64 + c + 4);
            const float* rs = rstd + t * 64 + c;
            u32x4 w; w.x = pk(v0[0] * rs[0], v0[1] * rs[1]); w.y = pk(v0[2] * rs[2], v0[3] * rs[3]); w.z = pk(v1[0] * rs[4], v1[1] * rs[5]); w.w = pk(v1[2] * rs[6], v1[3] * rs[7]);
            *(u32x4*)(lds + t * 16384 + b) = w;
        }
    WAIT_VM0();
    __syncthreads();
    f32x4 acc[4][4];
#pragma unroll
    for (int m = 0; m < 4; ++m)
#pragma unroll
        for (int n = 0; n < 4; ++n) acc[m][n] = (f32x4){0.f, 0.f, 0.f, 0.f};
    { const unsigned la = lds_addr(lds) + lds_byte(wr * 64 + fr, fq * 8), lb = lds_addr(lds) + 32768 + lds_byte(wc * 64 + fr, fq * 8);
      compute_ktile<4>(la, lb, acc);
      compute_ktile<4>(la + 16384, lb + 32768, acc); }
    const bf16_t* U = (const bf16_t*)(p.ws + O_U);
    bf16_t* ABR = (bf16_t*)(p.ws + O_ABR);
    const float* gain = p.in[12] + (size_t)l * D;
    const float* bs = p.in[14] + (size_t)(l * 4 + g) * 128;
#pragma unroll
    for (int m = 0; m < 4; ++m) {
        const int pr = wr * 64 + m * 16 + fr;
        const float bias = bs[pr];
#pragma unroll
        for (int n = 0; n < 4; ++n) {
            const int col = c0 + wc * 64 + n * 16 + fq * 4;
            const f32x4 gn = *(const f32x4*)(gain + col);
            const u32x2 uv = *(const u32x2*)(U + (size_t)(m0 + pr) * D + col);
            f32x4 u; u[0] = __uint_as_float(uv.x << 16); u[1] = __uint_as_float(uv.x & 0xffff0000u); u[2] = __uint_as_float(uv.y << 16); u[3] = __uint_as_float(uv.y & 0xffff0000u);
            store_bf4(ABR + (size_t)(m0 + pr) * D + col, u * (gn * acc[m][n] + bias));
        }
    }
}

__device__ void attn_item(const Params& p, int l, bool ctx, int b, int h, int qt, unsigned char* lds) {
    const int tid = otid(), wid = tid >> 6, lane = tid & 63, fr = lane & 15, fq = lane >> 4;
    const int qrow0 = (ctx ? b * 256 : RC + b * 1024) + qt * 128 + wid * 16;
    const bf16_t* Kb = ctx ? (const bf16_t*)(p.ws + O_KC) + (size_t)(b * 256) * 1024 + h * 128
                           : (const bf16_t*)(p.ws + O_KL) + ((size_t)(l * 2 + b) * 1280) * 1024 + h * 128;
    const int ldv = ctx ? 256 : 1280;
    const bf16_t* Vb = ctx ? (const bf16_t*)(p.ws + O_VTC) + ((size_t)(b * 8 + h) * 128) * 256
                           : (const bf16_t*)(p.ws + O_VTL) + ((size_t)((l * 2 + b) * 8 + h) * 128) * 1280;
    const int nt = ctx ? 4 : 20;
    const float* lp = p.in[15] + (size_t)l * 256;
    float e1 = lp[lane] * lp[64 + lane], e2 = lp[128 + lane] * lp[192 + lane];
#pragma unroll
    for (int o = 32; o >= 1; o >>= 1) { e1 += __shfl_xor(e1, o); e2 += __shfl_xor(e2, o); }
    const float lam_init = 0.8f - 0.6f * fexp(-0.3f * (float)l);
    const float lam = fexp(e1) - fexp(e2) + lam_init;
    const bf16_t* Q = (const bf16_t*)(p.ws + O_Q) + (size_t)(qrow0 + fr) * 1024 + h * 128;
    bf16x8 qf[2][2];
#pragma unroll
    for (int i2 = 0; i2 < 2; ++i2)
#pragma unroll
        for (int ks = 0; ks < 2; ++ks) qf[i2][ks] = *(const bf16x8*)(Q + i2 * 64 + ks * 32 + fq * 8);
    f32x4 O1[8], O2[8];
#pragma unroll
    for (int e = 0; e < 8; ++e) { O1[e] = (f32x4){0.f, 0.f, 0.f, 0.f}; O2[e] = O1[e]; }
    float mrun[2] = {-1e30f, -1e30f}, lsum[2] = {0.f, 0.f};

    __syncthreads();
#define STAGE_KV(s, t)                                                                                             \
    do {                                                                                                           \
        _Pragma("unroll") for (int i = 0; i < 2; ++i) {                                                            \
            const int P = tid + i * 512;                                                                           \
            const int key = P >> 4, c = (P & 15) ^ (key & 15);                                                     \
            glds16(Kb + (size_t)((t) * 64 + key) * 1024 + c * 8, lds + (s) * 32768 + P * 16);                      \
        }                                                                                                          \
        _Pragma("unroll") for (int i = 0; i < 2; ++i) {                                                            \
            const int P = tid + i * 512;                                                                           \
            const int e = P >> 3, c = (P & 7) ^ ((e >> 1) & 7);                                                    \
            glds16(Vb + (size_t)e * ldv + (t) * 64 + c * 8, lds + (s) * 32768 + 16384 + P * 16);                   \
        }                                                                                                          \
    } while (0)
    unsigned aK[2][2], aV[2][2];
    {
        const unsigned lb0 = lds_addr(lds), sw = (unsigned)(fr >> 1) & 7u;
#pragma unroll
        for (int i2 = 0; i2 < 2; ++i2)
#pragma unroll
            for (int ks = 0; ks < 2; ++ks) aK[i2][ks] = lb0 + fr * 256 + ((((unsigned)(i2 * 8 + ks * 4 + fq)) ^ (unsigned)fr) << 4);
#pragma unroll
        for (int kk = 0; kk < 2; ++kk)
#pragma unroll
            for (int h2 = 0; h2 < 2; ++h2) aV[kk][h2] = lb0 + 16384 + fr * 128 + ((((unsigned)(kk * 4 + (fq >> 1) + 2 * h2)) ^ sw) << 4) + (fq & 1) * 8;
    }
#define LDS_RD64(dst, base, off) asm volatile("ds_read_b64 %0, %1 offset:" #off : "=v"(dst) : "v"(base) : "memory")
    STAGE_KV(0, 0); STAGE_KV(1, 1);
    int cur = 0, nxt = 2;
    for (int t = 0; t < nt; ++t) {
        if (t + 1 < nt) asm volatile("s_waitcnt vmcnt(4)" ::: "memory"); else asm volatile("s_waitcnt vmcnt(0)" ::: "memory");
        __builtin_amdgcn_sched_barrier(0);
        asm volatile("" ::: "memory");
        __builtin_amdgcn_s_barrier();
        asm volatile("" ::: "memory");
        __builtin_amdgcn_sched_barrier(0);
        if (t + 2 < nt) STAGE_KV(nxt, t + 2);
        const unsigned off = (unsigned)cur * 32768u;
        cur = (cur == 2) ? 0 : cur + 1; nxt = (nxt == 2) ? 0 : nxt + 1;
        f32x4 s[2][4];
        {
            bf16x8 kf[2][4][2];
            const unsigned k00 = aK[0][0] + off, k01 = aK[0][1] + off, k10 = aK[1][0] + off, k11 = aK[1][1] + off;
            LDS_RD(kf[0][0][0], k00, 0); LDS_RD(kf[0][0][1], k01, 0); LDS_RD(kf[0][1][0], k00, 4096); LDS_RD(kf[0][1][1], k01, 4096);
            LDS_RD(kf[0][2][0], k00, 8192); LDS_RD(kf[0][2][1], k01, 8192); LDS_RD(kf[0][3][0], k00, 12288); LDS_RD(kf[0][3][1], k01, 12288);
            LDS_RD(kf[1][0][0], k10, 0); LDS_RD(kf[1][0][1], k11, 0); LDS_RD(kf[1][1][0], k10, 4096); LDS_RD(kf[1][1][1], k11, 4096);
            LDS_RD(kf[1][2][0], k10, 8192); LDS_RD(kf[1][2][1], k11, 8192); LDS_RD(kf[1][3][0], k10, 12288); LDS_RD(kf[1][3][1], k11, 12288);
            __builtin_amdgcn_sched_barrier(0);
            asm volatile("s_waitcnt lgkmcnt(8)" ::: "memory");
            __builtin_amdgcn_sched_barrier(0);
#pragma unroll
            for (int kt = 0; kt < 4; ++kt) {
                s[0][kt] = __builtin_amdgcn_mfma_f32_16x16x32_bf16(kf[0][kt][0], qf[0][0], (f32x4){0.f, 0.f, 0.f, 0.f}, 0, 0, 0);
                s[0][kt] = __builtin_amdgcn_mfma_f32_16x16x32_bf16(kf[0][kt][1], qf[0][1], s[0][kt], 0, 0, 0);
            }
            __builtin_amdgcn_sched_barrier(0);
            asm volatile("s_waitcnt lgkmcnt(0)" ::: "memory");
            __builtin_amdgcn_sched_barrier(0);
#pragma unroll
            for (int kt = 0; kt < 4; ++kt) {
                s[1][kt] = __builtin_amdgcn_mfma_f32_16x16x32_bf16(kf[1][kt][0], qf[1][0], (f32x4){0.f, 0.f, 0.f, 0.f}, 0, 0, 0);
                s[1][kt] = __builtin_amdgcn_mfma_f32_16x16x32_bf16(kf[1][kt][1], qf[1][1], s[1][kt], 0, 0, 0);
            }
            __builtin_amdgcn_sched_barrier(0);
        }
        bf16x8 pf[2][2];
#pragma unroll
        for (int i2 = 0; i2 < 2; ++i2) {
            float mx = -1e30f;
#pragma unroll
            for (int kt = 0; kt < 4; ++kt)
#pragma unroll
                for (int j = 0; j < 4; ++j) mx = fmaxf(mx, s[i2][kt][j]);
            if (__builtin_amdgcn_ballot_w64(mx > mrun[i2] + 8.f) != 0) {
                mx = fmaxf(mx, __shfl_xor(mx, 16)); mx = fmaxf(mx, __shfl_xor(mx, 32));
                const float mn = fmaxf(mrun[i2], mx);
                const float alpha = fexp2(mrun[i2] - mn);
                mrun[i2] = mn;
                lsum[i2] *= alpha;
                if (i2 == 0) {
#pragma unroll
                    for (int e = 0; e < 8; ++e) O1[e] = O1[e] * alpha;
                } else {
#pragma unroll
                    for (int e = 0; e < 8; ++e) O2[e] = O2[e] * alpha;
                }
            }
            const float mn = mrun[i2];
            float ps = 0.f;
#pragma unroll
            for (int kt = 0; kt < 4; ++kt)
#pragma unroll
                for (int j = 0; j < 4; ++j) { const float pv = fexp2(s[i2][kt][j] - mn); s[i2][kt][j] = pv; ps += pv; }
            lsum[i2] += ps;
#pragma unroll
            for (int kk = 0; kk < 2; ++kk) {
                u32x4 w;
                w.x = pk(s[i2][2 * kk][0], s[i2][2 * kk][1]); w.y = pk(s[i2][2 * kk][2], s[i2][2 * kk][3]);
                w.z = pk(s[i2][2 * kk + 1][0], s[i2][2 * kk + 1][1]); w.w = pk(s[i2][2 * kk + 1][2], s[i2][2 * kk + 1][3]);
                pf[i2][kk] = __builtin_bit_cast(bf16x8, w);
            }
        }
        {
            const unsigned v00 = aV[0][0] + off, v01 = aV[0][1] + off, v10 = aV[1][0] + off, v11 = aV[1][1] + off;
            u32x2 vl[8][2], vh[8][2];
#define RDV(et, o) do { LDS_RD64(vl[et][0], v00, o); LDS_RD64(vh[et][0], v01, o); LDS_RD64(vl[et][1], v10, o); LDS_RD64(vh[et][1], v11, o); } while (0)
#define PV_STEP(et, WAITN) do { __builtin_amdgcn_sched_barrier(0); asm volatile("s_waitcnt lgkmcnt(" #WAITN ")" ::: "memory"); __builtin_amdgcn_sched_barrier(0); \
            _Pragma("unroll") for (int kk = 0; kk < 2; ++kk) { u32x4 w; w.x = vl[et][kk].x; w.y = vl[et][kk].y; w.z = vh[et][kk].x; w.w = vh[et][kk].y; \
                const bf16x8 vf = __builtin_bit_cast(bf16x8, w); \
                O1[et] = __builtin_amdgcn_mfma_f32_16x16x32_bf16(vf, pf[0][kk], O1[et], 0, 0, 0); O2[et] = __builtin_amdgcn_mfma_f32_16x16x32_bf16(vf, pf[1][kk], O2[et], 0, 0, 0); } \
            __builtin_amdgcn_sched_barrier(0); } while (0)
            RDV(0, 0); RDV(1, 2048); RDV(2, 4096);
            PV_STEP(0, 8); RDV(3, 6144);
            PV_STEP(1, 8); RDV(4, 8192);
            PV_STEP(2, 8); RDV(5, 10240);
            PV_STEP(3, 8); RDV(6, 12288);
            PV_STEP(4, 8); RDV(7, 14336);
            PV_STEP(5, 8);
            PV_STEP(6, 4);
            PV_STEP(7, 0);
#undef PV_STEP
#undef RDV
        }
    }
#undef STAGE_KV
    float l1 = lsum[0], l2 = lsum[1];
    l1 += __shfl_xor(l1, 16); l1 += __shfl_xor(l1, 32);
    l2 += __shfl_xor(l2, 16); l2 += __shfl_xor(l2, 32);
    const float i1 = 1.f / l1, i2s = lam / l2;
    float ss = 0.f;
#pragma unroll
    for (int e = 0; e < 8; ++e) {
        O1[e] = O1[e] * i1 - O2[e] * i2s;
        ss += O1[e][0] * O1[e][0] + O1[e][1] * O1[e][1] + O1[e][2] * O1[e][2] + O1[e][3] * O1[e][3];
    }
    ss += __shfl_xor(ss, 16); ss += __shfl_xor(ss, 32);
    const float rn = __builtin_amdgcn_rsqf(ss * (1.f / 128.f) + EPS) * (1.f - lam_init);
    const float* sg = p.in[16] + (size_t)l * 128;
    bf16_t* BBR = (bf16_t*)(p.ws + O_BBR) + (size_t)(qrow0 + fr) * 1024 + h * 128;
#pragma unroll
    for (int e = 0; e < 8; ++e) {
        const f32x4 gn = *(const f32x4*)(sg + e * 16 + fq * 4);
        store_bf4(BBR + e * 16 + fq * 4, O1[e] * rn * gn);
    }
}

__device__ void phase_mix(const Params& p, int l, unsigned char* lds) {
    constexpr int NQ = 16 + 32 + 24;
    unsigned* ctr = (unsigned*)(p.ws + O_BAR + 14336) + l * 128;
    volatile int* slot = (volatile int*)(lds + LDS_X + 528);
    const int x0 = (int)blockIdx.x & 7;
    for (int dq = 0; dq < 8; ++dq) {
        const int q = (x0 + dq) & 7;
        for (;;) {
            __syncthreads();
            if (threadIdx.x == 0) *slot = (int)__hip_atomic_fetch_add(ctr + q * 16, 1u, __ATOMIC_RELAXED, __HIP_MEMORY_SCOPE_AGENT);
            __syncthreads();
            const int k = *slot;
            if (k >= NQ) break;
            if (k < 16) attn_item(p, l, false, k >> 3, q, k & 7, lds);
            else if (k < 48) attn_item(p, l, true, (k - 16) >> 1, q, (k - 16) & 1, lds);
            else spatial_item(p, l, q * 24 + (k - 48), lds);
        }
    }
}

#define XB_TMO      128
#define XB_XCNT(j)  (256  + 64 * (j))
#define XB_XSUB(j)  (1280 + 64 * (j))
#define XB_XGEN(j)  (2304 + 64 * (j))
#define XB_TOP      3328
#define XB_TOPGEN   3392
#define XCD_BAR_WORDS 3456
#define XB_SPIN_CAP (1u << 18)
#define LAS __attribute__((address_space(3)))

__device__ __forceinline__ unsigned xb_ld(unsigned* p)              { return __hip_atomic_load(p, __ATOMIC_RELAXED, __HIP_MEMORY_SCOPE_AGENT); }
__device__ __forceinline__ unsigned xb_add(unsigned* p, unsigned v) { return __hip_atomic_fetch_add(p, v, __ATOMIC_RELAXED, __HIP_MEMORY_SCOPE_AGENT); }
__device__ __forceinline__ unsigned xb_xcc_id() { return (unsigned)__builtin_amdgcn_s_getreg((3 << 11) | 20) & 0xFu; }
#define XB_SPIN(cond, bar) do { unsigned _sp = 0; while (cond) { __builtin_amdgcn_s_sleep(1); \
    if ((++_sp & 255u) == 0u) { if (xb_ld(&(bar)[XB_TMO])) break; if (_sp > XB_SPIN_CAP) { atomicAdd(&(bar)[XB_TMO], 1u); break; } } } } while (0)

struct XcdBarrier {
    unsigned* bar; unsigned x;
    volatile LAS unsigned* st;
};

__device__ __forceinline__ XcdBarrier xcd_barrier_post(unsigned* bar, volatile LAS unsigned* st) {
    XcdBarrier b; b.bar = bar; b.x = xb_xcc_id(); b.st = st;
    if (threadIdx.x == 0) (void)xb_add(&bar[XB_XCNT(b.x)], 1u);
    return b;
}
__device__ __forceinline__ void xcd_barrier_complete(unsigned* bar, unsigned x, unsigned& nloc, unsigned& nx) {
    const unsigned G = gridDim.x * gridDim.y * gridDim.z;
    unsigned sum, cnt, mine, sp = 0u;
    for (;;) {
        sum = 0u; cnt = 0u; mine = 0u;
#pragma unroll
        for (unsigned j = 0; j < 16; ++j) { const unsigned c = xb_ld(&bar[XB_XCNT(j)]); sum += c; cnt += (c > 0u) ? 1u : 0u; mine = (j == x) ? c : mine; }
        if (sum == G) break;
        __builtin_amdgcn_s_sleep(1);
        if ((++sp & 255u) == 0u) { if (xb_ld(&bar[XB_TMO])) break; if (sp > XB_SPIN_CAP) { atomicAdd(&bar[XB_TMO], 1u); break; } }
    }
    nloc = mine > 0u ? mine : 1u; nx = cnt > 0u ? cnt : 1u;
}

__device__ __forceinline__ void xcd_barrier(const XcdBarrier& b) {
    asm volatile("s_waitcnt vmcnt(0)" ::: "memory");
    __syncthreads();
    if (threadIdx.x == 0) {
        unsigned* bar = b.bar;
        __builtin_amdgcn_s_waitcnt(0);
        unsigned nloc = b.st[0], nx = b.st[1];
        if (nloc == 0u) { xcd_barrier_complete(bar, b.x, nloc, nx); b.st[0] = nloc; b.st[1] = nx; }
        const unsigned old = xb_add(&bar[XB_XSUB(b.x)], 1u);
        const unsigned gen = old / nloc;
        if (old + 1u == (gen + 1u) * nloc) {
            __builtin_amdgcn_fence(__ATOMIC_RELEASE, "agent");
            asm volatile("s_waitcnt vmcnt(0)" ::: "memory");
            const unsigned og = xb_add(&bar[XB_TOP], 1u);
            const unsigned tg = og / nx;
            if (og + 1u == (tg + 1u) * nx) xb_add(&bar[XB_TOPGEN], 1u);
            else XB_SPIN(xb_ld(&bar[XB_TOPGEN]) == tg, bar);
            __builtin_amdgcn_fence(__ATOMIC_ACQUIRE, "agent");
            xb_add(&bar[XB_XGEN(b.x)], 1u);
            asm volatile("s_waitcnt vmcnt(0)" ::: "memory");
        } else {
            XB_SPIN(xb_ld(&bar[XB_XGEN(b.x)]) == gen, bar);
            __builtin_amdgcn_fence(__ATOMIC_ACQUIRE, "agent");
            asm volatile("s_waitcnt vmcnt(0)" ::: "memory");
        }
    }
    __syncthreads();
}


constexpr int NPHASE = 46;
__device__ void run_phase(const Params& p, int ph, unsigned char* lds) {
    if (ph == 0) { phase_prologue(p, lds); return; }
    if (ph == NPHASE - 1) { phase_norm(p, 0, 3); return; }
    const int l = (ph - 1) / 11, s = (ph - 1) % 11;
    switch (s) {
        case 0: phase_norm(p, l, 0); break;
        case 1: phase_gemm<G_UP>(p, l, 0, lds); break;
        case 2: phase_gemm<G_DOWN>(p, l, 0, lds); break;
        case 3: phase_norm(p, l, 1); break;
        case 4: phase_gemm<G_WIN>(p, l, 0, lds); break;
        case 5: phase_mix(p, l, lds); break;
        case 6: phase_gemm<G_BR>(p, l, 0, lds); break;
        case 7: phase_gemm<G_OUT>(p, l, 0, lds); break;
        case 8: phase_norm(p, l, 2); break;
        case 9: phase_gemm<G_UP>(p, l, 1, lds); break;
        default: phase_gemm<G_DOWN>(p, l, 1, lds); break;
    }
}

__global__ void __launch_bounds__(NTHR, 2) fwd_kernel(Params p) {
    extern __shared__ __attribute__((aligned(16))) unsigned char lds[];
#if COOP
    cg::grid_group grid = cg::this_grid();
    volatile LAS unsigned* st = (volatile LAS unsigned*)(lds + LDS_X + 512);
    if (threadIdx.x == 0) { st[0] = 0u; st[1] = 0u; st[2] = 0u; st[3] = 0u; }
    __syncthreads();
    XcdBarrier xb = xcd_barrier_post((unsigned*)(p.ws + O_BAR), st);
    for (int ph = p.ph_lo; ph < p.ph_hi; ++ph) {
#ifdef PROBE_DUP
        { const int s_ = (ph == 0) ? 16 : (ph == NPHASE - 1 ? 17 : (ph - 1) % 11);
          const int nrep = ((PROBE_DUP >> s_) & 1) ? 2 : 1;
          for (int rep = 0; rep < nrep; ++rep) { if (rep) xcd_barrier(xb); run_phase(p, ph, lds); }
          if ((PROBE_DUP >> 20) & 1) { xcd_barrier(xb); } }
#else
        run_phase(p, ph, lds);
#endif
        if (ph + 1 < p.ph_hi) { if (p.ph_lo < 0) grid.sync(); else xcd_barrier(xb); }
    }
#else
    for (int ph = p.ph_lo; ph < p.ph_hi; ++ph) run_phase(p, ph, lds);
#endif
}

extern "C" void kernel_launch(void* const* d_in, const int* in_sizes, int n_in, void* d_out, int out_size, void* d_ws, size_t ws_size, hipStream_t stream) {
    static int grid_blocks = 0;
    if (!grid_blocks) {
        int dev = 0, cus = 0, per_cu = 0;
        hipGetDevice(&dev);
        hipDeviceGetAttribute(&cus, hipDeviceAttributeMultiprocessorCount, dev);
        hipFuncSetAttribute((const void*)fwd_kernel, hipFuncAttributeMaxDynamicSharedMemorySize, LDS_BYTES);
        hipOccupancyMaxActiveBlocksPerMultiprocessor(&per_cu, (const void*)fwd_kernel, NTHR, LDS_BYTES);
        if (per_cu < 1) per_cu = 1;
        if (per_cu > 1) per_cu = 1;
        grid_blocks = cus * per_cu;
        if (n_in != 23 || ws_size < WS_END) fprintf(stderr, "kernel_launch: unexpected n_in %d or ws_size %zu (need %zu)\n", n_in, ws_size, (size_t)WS_END);
    }
    Params p{};
    for (int i = 0; i < 23; ++i) p.in[i] = (const float*)d_in[i];
    p.out = (float*)d_out; p.ws = (unsigned char*)d_ws;
#if COOP
    p.ph_lo = 0; p.ph_hi = NPHASE;
    (void)hipMemsetAsync((unsigned char*)d_ws + O_BAR, 0, 16384, stream);
    void* args[] = {&p};
    hipError_t e = hipLaunchCooperativeKernel((const void*)fwd_kernel, dim3(grid_blocks), dim3(NTHR), args, LDS_BYTES, stream);
    if (e != hipSuccess) fprintf(stderr, "cooperative launch failed: %s (grid %d)\n", hipGetErrorString(e), grid_blocks);
#else
    for (int ph = 0; ph < NPHASE; ++ph) {
        p.ph_lo = ph; p.ph_hi = ph + 1;
        hipLaunchKernelGGL(fwd_kernel, dim3(grid_blocks), dim3(NTHR), LDS_BYTES, stream, p);
    }
#endif
}
```

```cpp
#include <hip/hip_runtime.h>
#include <hip/hip_cooperative_groups.h>
#include <cstdio>
#include <cstdint>
namespace cg = cooperative_groups;

#ifndef COOP
#define COOP 1
#endif

typedef unsigned short bf16_t;
typedef short bf16x8 __attribute__((ext_vector_type(8)));
typedef short s16x4 __attribute__((ext_vector_type(4)));
typedef float f32x4 __attribute__((ext_vector_type(4)));
typedef float f32x2 __attribute__((ext_vector_type(2)));
typedef __bf16 bf16x2_t __attribute__((ext_vector_type(2)));
typedef unsigned u32x2 __attribute__((ext_vector_type(2)));
typedef unsigned u32x4 __attribute__((ext_vector_type(4)));

#define DI __device__ __forceinline__

constexpr int R = 6144;
constexpr int RC = 4096;
constexpr int D = 1024;
constexpr int DFF = 2816;
constexpr int INW = 7168;
constexpr int NTHR = 512;
constexpr int LDS_X = 147456;
constexpr int LDS_BYTES = LDS_X + 1024;
constexpr float EPS = 1e-6f;

constexpr size_t al(size_t x) { return (x + 255) & ~(size_t)255; }
constexpr size_t O_X = 0;
constexpr size_t O_H = al(O_X + (size_t)R * D * 4);
constexpr size_t O_ACT = al(O_H + (size_t)R * D * 2);
constexpr size_t O_U = al(O_ACT + (size_t)R * DFF * 2);
constexpr size_t O_VT = al(O_U + (size_t)R * D * 2);
constexpr size_t O_VSS = al(O_VT + (size_t)R * D * 2);
constexpr size_t O_Q = al(O_VSS + (size_t)R * 16 * 4);
constexpr size_t O_KC = al(O_Q + (size_t)R * D * 2);
constexpr size_t O_KL = al(O_KC + (size_t)RC * D * 2);
constexpr size_t O_VTC = al(O_KL + (size_t)8 * 1280 * D * 2);
constexpr size_t O_VTL = al(O_VTC + (size_t)16 * 8 * 128 * 256 * 2);
constexpr size_t O_SG = al(O_VTL + (size_t)8 * 8 * 128 * 1280 * 2);
constexpr size_t O_ABR = al(O_SG + (size_t)R * 2048 * 2);
constexpr size_t O_BBR = al(O_ABR + (size_t)R * D * 2);
constexpr size_t O_MG = al(O_BBR + (size_t)R * D * 2);
constexpr size_t O_MG1 = al(O_MG + (size_t)R * D * 2);
constexpr size_t O_MOD = al(O_MG1 + (size_t)R * D * 4);
constexpr size_t O_ROPE = al(O_MOD + (size_t)4 * 3 * 9216 * 4);
constexpr size_t O_W = al(O_ROPE + 8192);
constexpr size_t WE_13A = 0;
constexpr size_t WE_2A = WE_13A + (size_t)5632 * 1024;
constexpr size_t WE_IN = WE_2A + (size_t)1024 * 2816;
constexpr size_t WE_A = WE_IN + (size_t)7168 * 1024;
constexpr size_t WE_B = WE_A + (size_t)1024 * 1024;
constexpr size_t WE_O = WE_B + (size_t)1024 * 1024;
constexpr size_t WE_13B = WE_O + (size_t)1024 * 1024;
constexpr size_t WE_2B = WE_13B + (size_t)5632 * 1024;
constexpr size_t WE_LAYER = WE_2B + (size_t)1024 * 2816;
constexpr size_t O_BAR = al(O_W + WE_LAYER * 4 * 2);
constexpr size_t WS_END = O_BAR + 16384;

struct Params {
    const float* in[23];
    float* out;
    unsigned char* ws;
    int ph_lo, ph_hi;
};

DI unsigned pk(float a, float b) { f32x2 v = {a, b}; bf16x2_t r = __builtin_convertvector(v, bf16x2_t); return __builtin_bit_cast(unsigned, r); }
DI float bf2f(bf16_t v) { return __uint_as_float(((unsigned)v) << 16); }
DI float bfround(float a) { unsigned u = pk(a, 0.f); return __uint_as_float(u << 16); }
DI float fexp2(float x) { return __builtin_amdgcn_exp2f(x); }
DI float fexp(float x) { return __builtin_amdgcn_exp2f(x * 1.44269504089f); }
DI float frcp(float x) { return __builtin_amdgcn_rcpf(x); }
DI float sigmoidf_(float x) { return frcp(1.f + fexp(-x)); }
DI float siluf_(float x) { return x * sigmoidf_(x); }
DI float geluf_(float x) { float u = 0.7978845608f * (x + 0.044715f * x * x * x); return x * frcp(1.f + fexp(-2.f * u)); }
DI int otid() { int t = threadIdx.x; asm volatile("" : "+v"(t)); return t; }
DI int cond_of_row(int row) { return row < RC ? 0 : 1 + ((row - RC) >> 10); }

DI int lds_byte(int r, int c) { const int st = (r >> 4) * 2 + (c >> 5), rr = r & 15, cc = c & 31, ob = rr * 64 + cc * 2; return st * 1024 + (ob ^ (((ob >> 9) & 1) << 5)); }
DI void stage_rc(int b, int& Rr, int& Cc) { const int st = b / 1024, sb = b % 1024, swz = sb ^ (((sb >> 9) & 1) << 5); Rr = (st >> 1) * 16 + swz / 64; Cc = (st & 1) * 32 + (swz % 64) / 2; }

DI void glds16(const void* g, void* l) { __builtin_amdgcn_global_load_lds((const unsigned*)g, (unsigned*)l, 16, 0, 0); }
#define WAIT_VM0() asm volatile("s_waitcnt vmcnt(0)" ::: "memory")

template <int NI = 4>
DI void stage_half(unsigned char* buf, const bf16_t* src, int ld, int tid) {
#pragma unroll
    for (int i = 0; i < NI; ++i) {
        const int b = tid * 16 + i * 8192; int r, c; stage_rc(b, r, c);
        glds16(src + (size_t)r * ld + c, buf + b);
    }
}

#define LDS_RD(dst, base, off) asm volatile("ds_read_b128 %0, %1 offset:" #off : "=v"(dst) : "v"(base) : "memory")
template <int MI>
DI void compute_ktile(unsigned sa, unsigned sb, f32x4 (&acc)[MI][4]) {
    bf16x8 af[2][4], bw[2][4];
    LDS_RD(af[0][0], sa, 0); if (MI > 1) LDS_RD(af[0][1], sa, 2048); if (MI > 2) LDS_RD(af[0][2], sa, 4096); if (MI > 3) LDS_RD(af[0][3], sa, 6144);
    LDS_RD(bw[0][0], sb, 0); LDS_RD(bw[0][1], sb, 2048); LDS_RD(bw[0][2], sb, 4096); LDS_RD(bw[0][3], sb, 6144);
    LDS_RD(af[1][0], sa, 1024); if (MI > 1) LDS_RD(af[1][1], sa, 3072); if (MI > 2) LDS_RD(af[1][2], sa, 5120); if (MI > 3) LDS_RD(af[1][3], sa, 7168);
    LDS_RD(bw[1][0], sb, 1024); LDS_RD(bw[1][1], sb, 3072); LDS_RD(bw[1][2], sb, 5120); LDS_RD(bw[1][3], sb, 7168);
    __builtin_amdgcn_sched_barrier(0);
    if (MI == 4) asm volatile("s_waitcnt lgkmcnt(8)" ::: "memory"); else if (MI == 3) asm volatile("s_waitcnt lgkmcnt(7)" ::: "memory"); else if (MI == 2) asm volatile("s_waitcnt lgkmcnt(6)" ::: "memory"); else asm volatile("s_waitcnt lgkmcnt(5)" ::: "memory");
    __builtin_amdgcn_sched_barrier(0);
#pragma unroll
    for (int m = 0; m < MI; ++m)
#pragma unroll
        for (int n = 0; n < 4; ++n) acc[m][n] = __builtin_amdgcn_mfma_f32_16x16x32_bf16(bw[0][n], af[0][m], acc[m][n], 0, 0, 0);
    __builtin_amdgcn_sched_barrier(0);
    asm volatile("s_waitcnt lgkmcnt(0)" ::: "memory");
    __builtin_amdgcn_sched_barrier(0);
#pragma unroll
    for (int m = 0; m < MI; ++m)
#pragma unroll
        for (int n = 0; n < 4; ++n) acc[m][n] = __builtin_amdgcn_mfma_f32_16x16x32_bf16(bw[1][n], af[1][m], acc[m][n], 0, 0, 0);
    __builtin_amdgcn_sched_barrier(0);
}
DI unsigned lds_addr(const void* p) { return (unsigned)(uintptr_t)(const __attribute__((address_space(3))) unsigned char*)p; }

template <int MI>
DI void gemm_tile(const bf16_t* A, int lda, const bf16_t* Bt, int ldb, int K, int m0, int n0, f32x4 (&acc)[MI][4], unsigned char* lds) {
    const int tid = otid(), wid = tid >> 6, lane = tid & 63, wr = wid >> 1, wc = wid & 1, fr = lane & 15, fq = lane >> 4;
#pragma unroll
    for (int m = 0; m < MI; ++m)
#pragma unroll
        for (int n = 0; n < 4; ++n) acc[m][n] = (f32x4){0.f, 0.f, 0.f, 0.f};
    const bf16_t* Ab = A + (size_t)m0 * lda;
    const bf16_t* Bb = Bt + (size_t)n0 * ldb;
    const int nt = K >> 6;
    const unsigned la = lds_addr(lds) + lds_byte(wr * (MI * 16) + fr, fq * 8), lb = lds_addr(lds) + 32768 + lds_byte(wc * 64 + fr, fq * 8);
    __syncthreads();
    stage_half<MI>(lds, Ab, lda, tid);
    stage_half<2>(lds + 32768, Bb, ldb, tid);
    stage_half<MI>(lds + 49152, Ab + 64, lda, tid);
    stage_half<2>(lds + 49152 + 32768, Bb + 64, ldb, tid);
    int cur = 0, nxt = 2;
    for (int t = 0; t < nt; ++t) {
        if (t + 1 < nt) { if (MI == 4) asm volatile("s_waitcnt vmcnt(6)" ::: "memory"); else if (MI == 3) asm volatile("s_waitcnt vmcnt(5)" ::: "memory"); else if (MI == 2) asm volatile("s_waitcnt vmcnt(4)" ::: "memory"); else asm volatile("s_waitcnt vmcnt(3)" ::: "memory"); }
        else asm volatile("s_waitcnt vmcnt(0)" ::: "memory");
        __builtin_amdgcn_sched_barrier(0);
        asm volatile("" ::: "memory");
        __builtin_amdgcn_s_barrier();
        asm volatile("" ::: "memory");
        __builtin_amdgcn_sched_barrier(0);
        if (t + 2 < nt) {
            stage_half<MI>(lds + nxt * 49152, Ab + (t + 2) * 64, lda, tid);
            stage_half<2>(lds + nxt * 49152 + 32768, Bb + (t + 2) * 64, ldb, tid);
        }
        compute_ktile<MI>(la + cur * 49152, lb + cur * 49152, acc);
        cur = (cur == 2) ? 0 : cur + 1; nxt = (nxt == 2) ? 0 : nxt + 1;
    }
}

DI void store_bf4(bf16_t* p, f32x4 v) { u32x2 w; w.x = pk(v[0], v[1]); w.y = pk(v[2], v[3]); *(u32x2*)p = w; }

DI void transpose_tile(const float* __restrict__ src, int ld_src, bf16_t* __restrict__ dst, int ld_dst, int k0, int r0, int perm, float* tile_base) {
    const int tid = otid(), lt = tid & 255;
    float* tile = tile_base + (tid >> 8) * (64 * 65);
    const int ty = lt >> 4, tx = lt & 15, nn = tx * 4;
    const int scol = perm ? ((nn >> 5) * DFF + (r0 >> 7) * 64 + ((r0 >> 6) & 1) * 32 + (nn & 31)) : (r0 + nn);
    __syncthreads();
#pragma unroll
    for (int i = 0; i < 4; ++i) {
        const int kk = ty + 16 * i;
        const f32x4 v = __builtin_nontemporal_load((const f32x4*)(src + (size_t)(k0 + kk) * ld_src + scol));
        tile[kk * 65 + nn + 0] = v[0]; tile[kk * 65 + nn + 1] = v[1]; tile[kk * 65 + nn + 2] = v[2]; tile[kk * 65 + nn + 3] = v[3];
    }
    __syncthreads();
    const int n = lt >> 2, kc = lt & 3;
    u32x4 w0, w1;
    w0.x = pk(tile[(kc * 16 + 0) * 65 + n], tile[(kc * 16 + 1) * 65 + n]);
    w0.y = pk(tile[(kc * 16 + 2) * 65 + n], tile[(kc * 16 + 3) * 65 + n]);
    w0.z = pk(tile[(kc * 16 + 4) * 65 + n], tile[(kc * 16 + 5) * 65 + n]);
    w0.w = pk(tile[(kc * 16 + 6) * 65 + n], tile[(kc * 16 + 7) * 65 + n]);
    w1.x = pk(tile[(kc * 16 + 8) * 65 + n], tile[(kc * 16 + 9) * 65 + n]);
    w1.y = pk(tile[(kc * 16 + 10) * 65 + n], tile[(kc * 16 + 11) * 65 + n]);
    w1.z = pk(tile[(kc * 16 + 12) * 65 + n], tile[(kc * 16 + 13) * 65 + n]);
    w1.w = pk(tile[(kc * 16 + 14) * 65 + n], tile[(kc * 16 + 15) * 65 + n]);
    u32x4* d = (u32x4*)(dst + (size_t)(r0 + n) * ld_dst + k0 + kc * 16);
    d[0] = w0; d[1] = w1;
}

__device__ void phase_prologue(const Params& p, unsigned char* lds) {
    const int tid = otid();
    float* tile = (float*)lds;
    bf16_t* W = (bf16_t*)(p.ws + O_W);
    constexpr int NT_W = 27136 / 2, NT_MOD = 576, NT_CK = 512, NT_CV = 512 / 2, NT_X = 768;
    constexpr int TOTAL = NT_W + NT_MOD + NT_CK + NT_CV + NT_X + 1;
    for (int it = blockIdx.x; it < TOTAL; it += gridDim.x) {
        if (it < NT_W) {
            const int it2 = it * 2 + (tid >> 8);
            const int l = it2 / 6784, r = it2 % 6784;
            int widx, ti;
            if (r < 1408) { widx = 0; ti = r; } else if (r < 2112) { widx = 1; ti = r - 1408; } else if (r < 3904) { widx = 2; ti = r - 2112; }
            else if (r < 4160) { widx = 3; ti = r - 3904; } else if (r < 4416) { widx = 4; ti = r - 4160; } else if (r < 4672) { widx = 5; ti = r - 4416; }
            else if (r < 6080) { widx = 6; ti = r - 4672; } else { widx = 7; ti = r - 6080; }
            const float* src; int K, N, perm = 0; size_t we;
            switch (widx) {
                case 0: src = p.in[9]; K = 1024; N = 5632; perm = 1; we = WE_13A; break;
                case 1: src = p.in[10]; K = 2816; N = 1024; we = WE_2A; break;
                case 2: src = p.in[11]; K = 1024; N = 7168; we = WE_IN; break;
                case 3: src = p.in[17]; K = 1024; N = 1024; we = WE_A; break;
                case 4: src = p.in[18]; K = 1024; N = 1024; we = WE_B; break;
                case 5: src = p.in[19]; K = 1024; N = 1024; we = WE_O; break;
                case 6: src = p.in[20]; K = 1024; N = 5632; perm = 1; we = WE_13B; break;
                default: src = p.in[21]; K = 2816; N = 1024; we = WE_2B; break;
            }
            const int nkt = K >> 6;
            const int nrt = N >> 6;
            const int rt = ti % nrt, kt = ti / nrt;
            transpose_tile(src + (size_t)l * K * N, N, W + (size_t)l * WE_LAYER + we, K, kt * 64, rt * 64, perm, tile);
        } else if (it < NT_W + NT_MOD) {
            const int j = it - NT_W, l = j / 144, cb = j % 144;
            const int tx = tid & 15, kg = tid >> 4;
            const float* wm = p.in[6] + (size_t)l * 1024 * 9216 + cb * 64 + tx * 4;
            f32x4 a0 = {0.f, 0.f, 0.f, 0.f}, a1 = a0, a2 = a0;
#pragma unroll 8
            for (int k = kg; k < 1024; k += 32) {
                const f32x4 w = __builtin_nontemporal_load((const f32x4*)(wm + (size_t)k * 9216));
                const float s0 = siluf_(p.in[5][k]), s1 = siluf_(p.in[4][k]), s2 = siluf_(p.in[4][1024 + k]);
                a0 += w * s0; a1 += w * s1; a2 += w * s2;
            }
            __syncthreads();
            float* red = tile;
#pragma unroll
            for (int q = 0; q < 4; ++q) { red[(kg * 3 + 0) * 64 + tx * 4 + q] = a0[q]; red[(kg * 3 + 1) * 64 + tx * 4 + q] = a1[q]; red[(kg * 3 + 2) * 64 + tx * 4 + q] = a2[q]; }
            __syncthreads();
            if (tid < 192) {
                const int c = tid >> 6, col = tid & 63;
                float s = 0.f;
#pragma unroll
                for (int g = 0; g < 32; ++g) s += red[(g * 3 + c) * 64 + col];
                const int jc = cb * 64 + col;
                ((float*)(p.ws + O_MOD))[(size_t)(l * 3 + c) * 9216 + jc] = s + p.in[7][l * 9216 + jc];
            }
        } else if (it < NT_W + NT_MOD + NT_CK) {
            const int j = it - NT_W - NT_MOD;
            const size_t e0 = (size_t)j * 4096 + tid * 8;
            const int col = (int)(e0 & 1023), key = (int)((e0 >> 10) & 255), bl = (int)(e0 >> 18), b = bl >> 2, l = bl & 3;
            const f32x4 v0 = __builtin_nontemporal_load((const f32x4*)(p.in[2] + e0)), v1 = __builtin_nontemporal_load((const f32x4*)(p.in[2] + e0 + 4));
            u32x4 w; w.x = pk(v0[0], v0[1]); w.y = pk(v0[2], v0[3]); w.z = pk(v1[0], v1[1]); w.w = pk(v1[2], v1[3]);
            *(u32x4*)((bf16_t*)(p.ws + O_KL) + ((size_t)(l * 2 + b) * 1280 + key) * 1024 + col) = w;
        } else if (it < NT_W + NT_MOD + NT_CK + NT_CV) {
            const int j = (it - NT_W - NT_MOD - NT_CK) * 2 + (tid >> 8);
            const int et = j & 1, kt = (j >> 1) & 3, h = (j >> 3) & 7, l = (j >> 6) & 3, b = j >> 8;
            const float* src = p.in[3] + ((size_t)(b * 4 + l) * 256) * 1024 + h * 128;
            bf16_t* dst = (bf16_t*)(p.ws + O_VTL) + ((size_t)((l * 2 + b) * 8 + h) * 128) * 1280;
            transpose_tile(src, 1024, dst, 1280, kt * 64, et * 64, 0, tile);
        } else if (it == TOTAL - 1) {
            float* RT = (float*)(p.ws + O_ROPE);
#pragma unroll
            for (int i = 0; i < 2; ++i) {
                const int e = tid + i * 512, pos = e >> 4, fi = e & 15;
                const float ang = (float)pos * fexp2(-(float)fi * 0.8304820237f);
                float rev = ang * 0.15915494309f; rev -= floorf(rev);
                RT[e] = __builtin_amdgcn_cosf(rev); RT[1024 + e] = __builtin_amdgcn_sinf(rev);
            }
        } else {
            const int j = it - NT_W - NT_MOD - NT_CK - NT_CV;
            float* X = (float*)(p.ws + O_X);
#pragma unroll
            for (int i = 0; i < 4; ++i) {
                const size_t e = (size_t)j * 8192 + i * 2048 + tid * 4;
                const f32x4 v = (e < (size_t)RC * D) ? *(const f32x4*)(p.in[0] + e) : *(const f32x4*)(p.in[1] + (e - (size_t)RC * D));
                *(f32x4*)(X + e) = v;
            }
        }
    }
}

__device__ void phase_norm(const Params& p, int l, int which) {
    const int tid_ = otid(); const int lane = tid_ & 63, wid = tid_ >> 6;
    const float* X = (const float*)(p.ws + O_X);
    const float* MOD = (const float*)(p.ws + O_MOD);
    bf16_t* H = (bf16_t*)(p.ws + O_H);
    const bool affine = gridDim.x == 256;
    const int xg = (int)blockIdx.x & 7;
    const int gw = affine ? ((int)blockIdx.x >> 3) * 8 + wid : (int)blockIdx.x * 8 + wid, nw = affine ? 256 : (int)gridDim.x * 8;
    const int rend = affine ? 768 : R;
    for (int row0 = gw; row0 < rend; row0 += 3 * nw) {
        f32x4 v[3][4];
#pragma unroll
        for (int j = 0; j < 3; ++j) {
            int row = row0 + j * nw;
            if (affine) { const int rr = row0 + j * nw; row = (xg + 8 * (rr / 192)) * 192 + rr % 192; }
            if (row0 + j * nw < rend) {
#pragma unroll
                for (int i = 0; i < 4; ++i) v[j][i] = *(const f32x4*)(X + (size_t)row * D + i * 256 + lane * 4);
            }
        }
#pragma unroll
        for (int j = 0; j < 3; ++j) {
            int row = row0 + j * nw;
            if (affine) { const int rr = row0 + j * nw; row = (xg + 8 * (rr / 192)) * 192 + rr % 192; }
            if (row0 + j * nw < rend) {
                float ss = 0.f;
#pragma unroll
                for (int i = 0; i < 4; ++i) ss += v[j][i][0] * v[j][i][0] + v[j][i][1] * v[j][i][1] + v[j][i][2] * v[j][i][2] + v[j][i][3] * v[j][i][3];
#pragma unroll
                for (int o = 32; o >= 1; o >>= 1) ss += __shfl_xor(ss, o);
                const float r = __builtin_amdgcn_rsqf(ss * (1.f / 1024.f) + EPS);
                if (which < 3) {
                    const float* g = p.in[8] + (size_t)(l * 3 + which) * D;
                    const float* md = MOD + (size_t)(l * 3 + cond_of_row(row)) * 9216 + (size_t)(3 * which) * D;
#pragma unroll
                    for (int i = 0; i < 4; ++i) {
                        const int c = i * 256 + lane * 4;
                        const f32x4 gg = *(const f32x4*)(g + c), sh = *(const f32x4*)(md + c), sc = *(const f32x4*)(md + D + c);
                        store_bf4(H + (size_t)row * D + c, (v[j][i] * r) * gg * (sc + 1.f) + sh);
                    }
                } else {
#pragma unroll
                    for (int i = 0; i < 4; ++i) {
                        const int c = i * 256 + lane * 4;
                        *(f32x4*)(p.out + (size_t)row * D + c) = (v[j][i] * r) * (*(const f32x4*)(p.in[22] + c));
                    }
                }
            }
        }
    }
}

enum { G_UP = 0, G_DOWN = 1, G_WIN = 2, G_BR = 3, G_OUT = 4 };

template <int KIND, int MI>
DI void gemm_item(const Params& p, int l, int second, int m0, int ntile, unsigned char* lds) {
    const int tid = otid(), wid = tid >> 6, lane = tid & 63, wr = wid >> 1, wc = wid & 1, fr = lane & 15, fq = lane >> 4;
    const bf16_t* W = (const bf16_t*)(p.ws + O_W) + (size_t)l * WE_LAYER;
    const float* MOD = (const float*)(p.ws + O_MOD);
    float* X = (float*)(p.ws + O_X);
    const bf16_t* H = (const bf16_t*)(p.ws + O_H);
    bf16_t* ACT = (bf16_t*)(p.ws + O_ACT);
    constexpr int WMR = MI * 16;
    const int n0 = ntile * 128;
    {
        f32x4 acc[MI][4];
        if (KIND == G_UP) {
            gemm_tile<MI>(H, D, W + (second ? WE_13B : WE_13A), D, D, m0, n0, acc, lds);
#pragma unroll
            for (int m = 0; m < MI; ++m) {
                const int row = m0 + wr * WMR + m * 16 + fr;
#pragma unroll
                for (int nn = 0; nn < 2; ++nn) {
                    f32x4 o;
#pragma unroll
                    for (int j = 0; j < 4; ++j) o[j] = siluf_(acc[m][nn][j]) * acc[m][nn + 2][j];
                    store_bf4(ACT + (size_t)row * DFF + ntile * 64 + wc * 32 + nn * 16 + fq * 4, o);
                }
            }
        } else if (KIND == G_DOWN || KIND == G_OUT) {
            if (KIND == G_DOWN) gemm_tile<MI>(ACT, DFF, W + (second ? WE_2B : WE_2A), DFF, DFF, m0, n0, acc, lds);
            else gemm_tile<MI>((const bf16_t*)(p.ws + O_MG), D, W + WE_O, D, D, m0, n0, acc, lds);
            const int slot = (KIND == G_OUT) ? 5 : (second ? 8 : 2);
            const float scl = (KIND == G_OUT) ? 1.f : 0.5f;
#pragma unroll
            for (int m = 0; m < MI; ++m) {
                const int row = m0 + wr * WMR + m * 16 + fr;
                const float* gt = MOD + (size_t)(l * 3 + cond_of_row(row)) * 9216 + (size_t)slot * D;
#pragma unroll
                for (int n = 0; n < 4; ++n) {
                    const int col = n0 + wc * 64 + n * 16 + fq * 4;
                    const f32x4 g = *(const f32x4*)(gt + col) * scl;
                    f32x4* xp = (f32x4*)(X + (size_t)row * D + col);
                    *xp = *xp + g * acc[m][n];
                }
            }
        } else if (KIND == G_BR) {
            const bf16_t* SG = (const bf16_t*)(p.ws + O_SG);
            gemm_tile<MI>((const bf16_t*)(p.ws + O_ABR), D, W + WE_A, D, D, m0, n0, acc, lds);
            float* MG1 = (float*)(p.ws + O_MG1);
#pragma unroll
            for (int m = 0; m < MI; ++m) {
                const int row = m0 + wr * WMR + m * 16 + fr;
#pragma unroll
                for (int n = 0; n < 4; ++n) {
                    const int col = n0 + wc * 64 + n * 16 + fq * 4;
                    const u32x2 gv = *(const u32x2*)(SG + (size_t)row * 2048 + col);
                    f32x4 g; g[0] = __uint_as_float(gv.x << 16); g[1] = __uint_as_float(gv.x & 0xffff0000u); g[2] = __uint_as_float(gv.y << 16); g[3] = __uint_as_float(gv.y & 0xffff0000u);
                    *(f32x4*)(MG1 + (size_t)row * D + col) = g * acc[m][n];
                }
            }
            gemm_tile<MI>((const bf16_t*)(p.ws + O_BBR), D, W + WE_B, D, D, m0, n0, acc, lds);
            bf16_t* MG = (bf16_t*)(p.ws + O_MG);
#pragma unroll
            for (int m = 0; m < MI; ++m) {
                const int row = m0 + wr * WMR + m * 16 + fr;
#pragma unroll
                for (int n = 0; n < 4; ++n) {
                    const int col = n0 + wc * 64 + n * 16 + fq * 4;
                    const u32x2 gv = *(const u32x2*)(SG + (size_t)row * 2048 + 1024 + col);
                    f32x4 g; g[0] = __uint_as_float(gv.x << 16); g[1] = __uint_as_float(gv.x & 0xffff0000u); g[2] = __uint_as_float(gv.y << 16); g[3] = __uint_as_float(gv.y & 0xffff0000u);
                    const f32x4 m1 = *(const f32x4*)(MG1 + (size_t)row * D + col);
                    store_bf4(MG + (size_t)row * D + col, m1 + g * acc[m][n]);
                }
            }
        } else {
            gemm_tile<MI>(H, D, W + WE_IN, D, D, m0, n0, acc, lds);
            const bool ctx = m0 < RC;
            const int b = ctx ? (m0 >> 8) : ((m0 - RC) >> 10);
            const int pos0 = (ctx ? (m0 & 255) : ((m0 - RC) & 1023)) + wr * WMR;
            if (n0 < 1024) {
                bf16_t* U = (bf16_t*)(p.ws + O_U);
#pragma unroll
                for (int m = 0; m < MI; ++m)
#pragma unroll
                    for (int n = 0; n < 4; ++n) {
                        f32x4 o;
#pragma unroll
                        for (int j = 0; j < 4; ++j) o[j] = geluf_(acc[m][n][j]);
                        store_bf4(U + (size_t)(m0 + wr * WMR + m * 16 + fr) * D + n0 + wc * 64 + n * 16 + fq * 4, o);
                    }
            } else if (n0 < 2048) {
                bf16_t* VT = (bf16_t*)(p.ws + O_VT);
                float* VSS = (float*)(p.ws + O_VSS);
#pragma unroll
                for (int m = 0; m < MI; ++m) {
                    const int row = m0 + wr * WMR + m * 16 + fr;
                    float ss = 0.f;
#pragma unroll
                    for (int n = 0; n < 4; ++n)
#pragma unroll
                        for (int j = 0; j < 4; ++j) {
                            const float gq = bfround(geluf_(acc[m][n][j]));
                            ss += gq * gq;
                            const int ch = n0 - 1024 + wc * 64 + n * 16 + fq * 4 + j;
                            VT[(size_t)ch * R + row] = (bf16_t)(__float_as_uint(gq) >> 16);
                        }
                    ss += __shfl_xor(ss, 16); ss += __shfl_xor(ss, 32);
                    if (fq == 0) VSS[(size_t)row * 16 + ((n0 - 1024) >> 7) * 2 + wc] = ss;
                }
            } else if (n0 < 4096) {
                const bool isq = n0 < 3072;
                const int cb = (isq ? n0 - 2048 : n0 - 3072) + wc * 64;
                if (!isq && ctx) {
                    float* ok = p.out + (size_t)R * D + ((size_t)(b * 4 + l) * 256) * 1024;
#pragma unroll
                    for (int m = 0; m < MI; ++m) {
#pragma unroll
                        for (int n = 0; n < 4; ++n) __builtin_nontemporal_store(acc[m][n], (f32x4*)(ok + (size_t)(pos0 + m * 16 + fr) * 1024 + cb + n * 16 + fq * 4));
                        __builtin_amdgcn_sched_barrier(0);
                    }
                    __builtin_amdgcn_sched_barrier(0);
                }
                if (!ctx) {
                    const float* RC_ = (const float*)(p.ws + O_ROPE);
                    const f32x4 cr = *(const f32x4*)(RC_ + (pos0 >> 6) * 16 + fq * 4), sr = *(const f32x4*)(RC_ + 1024 + (pos0 >> 6) * 16 + fq * 4);
#pragma unroll
                    for (int m = 0; m < MI; ++m) {
                        const int gc = (pos0 & 63) + m * 16 + fr;
                        const f32x4 cc = *(const f32x4*)(RC_ + gc * 16 + fq * 4), sc = *(const f32x4*)(RC_ + 1024 + gc * 16 + fq * 4);
                        const f32x4 x1 = acc[m][0], x2 = acc[m][1], y1 = acc[m][2], y2 = acc[m][3];
                        acc[m][0] = x1 * cr - x2 * sr; acc[m][1] = x2 * cr + x1 * sr;
                        acc[m][2] = y1 * cc - y2 * sc; acc[m][3] = y2 * cc + y1 * sc;
                    }
                }
                bf16_t* dst; size_t rowbase;
                if (isq) { dst = (bf16_t*)(p.ws + O_Q); rowbase = (size_t)(m0 + wr * WMR); }
                else if (ctx) { dst = (bf16_t*)(p.ws + O_KC); rowbase = (size_t)(m0 + wr * WMR); }
                else { dst = (bf16_t*)(p.ws + O_KL); rowbase = (size_t)(l * 2 + b) * 1280 + 256 + pos0; }
                const float qs = isq ? 0.18033688011f : 1.f;
#pragma unroll
                for (int m = 0; m < MI; ++m) {
#pragma unroll
                    for (int n = 0; n < 4; ++n) store_bf4(dst + (rowbase + m * 16 + fr) * 1024 + cb + n * 16 + fq * 4, acc[m][n] * qs);
                    __builtin_amdgcn_sched_barrier(0);
                }
            } else if (n0 < 5120) {
                const int h = (n0 - 4096) >> 7;
                if (ctx) {
                    float* ov = p.out + (size_t)R * D + (size_t)16 * 4 * 256 * 1024 + ((size_t)(b * 4 + l) * 256) * 1024;
#pragma unroll
                    for (int m = 0; m < MI; ++m)
#pragma unroll
                        for (int n = 0; n < 4; ++n) __builtin_nontemporal_store(acc[m][n], (f32x4*)(ov + (size_t)(pos0 + m * 16 + fr) * 1024 + (n0 - 4096) + wc * 64 + n * 16 + fq * 4));
                }
                bf16_t* vt; int ldv, koff;
                if (ctx) { vt = (bf16_t*)(p.ws + O_VTC) + ((size_t)(b * 8 + h) * 128) * 256; ldv = 256; koff = pos0; }
                else { vt = (bf16_t*)(p.ws + O_VTL) + ((size_t)((l * 2 + b) * 8 + h) * 128) * 1280; ldv = 1280; koff = 256 + pos0; }
#pragma unroll
                for (int m = 0; m < MI; ++m)
#pragma unroll
                    for (int n = 0; n < 4; ++n)
#pragma unroll
                        for (int j = 0; j < 4; ++j) {
                            const int e = wc * 64 + n * 16 + fq * 4 + j;
                            vt[(size_t)e * ldv + koff + m * 16 + fr] = (bf16_t)(pk(acc[m][n][j], 0.f) & 0xffffu);
                            if (j == 3) __builtin_amdgcn_sched_barrier(0);
                        }
            } else {
                bf16_t* SG = (bf16_t*)(p.ws + O_SG);
#pragma unroll
                for (int m = 0; m < MI; ++m)
#pragma unroll
                    for (int n = 0; n < 4; ++n) {
                        f32x4 o;
#pragma unroll
                        for (int j = 0; j < 4; ++j) o[j] = sigmoidf_(acc[m][n][j]);
                        store_bf4(SG + (size_t)(m0 + wr * WMR + m * 16 + fr) * 2048 + (n0 - 5120) + wc * 64 + n * 16 + fq * 4, o);
                    }
            }
        }
    }
}

template <int KIND>
__device__ void phase_gemm(const Params& p, int l, int second, unsigned char* lds) {
    const int G = (int)gridDim.x, bid = (int)blockIdx.x;
    if (KIND == G_UP || KIND == G_WIN) {
        const int NTN = (KIND == G_UP) ? 44 : 56, ntiles = 24 * NTN;
        if (KIND == G_WIN && (G & 7) == 0) {
            const int x = bid & 7, lb = bid >> 3, nb = G >> 3, nloc = 24 * 7;
            const int nfull = (nloc / nb) * nb, nrem = nloc - nfull;
            auto ntile_of = [&](int ni) { return ni == 0 ? 16 + x : ni == 1 ? 24 + x : ni == 2 ? 32 + x : ni < 5 ? 2 * x + (ni - 3) : 40 + 2 * x + (ni - 5); };
            for (int j = lb; j < nfull; j += nb) gemm_item<KIND, 4>(p, l, second, (j / 7) * 256, ntile_of(j % 7), lds);
            for (int q = lb; q < nrem * 4; q += nb) { const int j = nfull + (q >> 2); gemm_item<KIND, 1>(p, l, second, (j / 7) * 256 + (q & 3) * 64, ntile_of(j % 7), lds); }
        } else if ((G & 7) == 0) {
            const int x = bid & 7, lb = bid >> 3, nb = G >> 3, mx = x & 3, nx = x >> 2, npx = NTN >> 1, nloc = 6 * npx;
            const int nfull = (nloc / nb) * nb, nrem = nloc - nfull;
            for (int j = lb; j < nfull; j += nb) gemm_item<KIND, 4>(p, l, second, (mx * 6 + j % 6) * 256, nx * npx + j / 6, lds);
            for (int q = lb; q < nrem * 4; q += nb) { const int j = nfull + (q >> 2); gemm_item<KIND, 1>(p, l, second, (mx * 6 + j % 6) * 256 + (q & 3) * 64, nx * npx + j / 6, lds); }
        } else {
            const int nfull = (ntiles / G) * G, nrem = ntiles - nfull;
            for (int t = bid; t < nfull; t += G) gemm_item<KIND, 4>(p, l, second, (t % 24) * 256, t / 24, lds);
            for (int j = bid; j < nrem * 4; j += G) { const int t = nfull + (j >> 2); gemm_item<KIND, 1>(p, l, second, (t % 24) * 256 + (j & 3) * 64, t / 24, lds); }
        }
    } else {
        for (int t = bid; t < 32 * 8; t += G) gemm_item<KIND, 3>(p, l, second, (t % 32) * 192, t / 32, lds);
    }
}

__device__ void spatial_item(const Params& p, int l, int item, unsigned char* lds) {
    const int tid = otid(), wid = tid >> 6, lane = tid & 63, wr = wid >> 2, wc = wid & 3, fr = lane & 15, fq = lane >> 4;
    const int g = item & 3, ck = item >> 2;
    const int m0 = ck * 128, c0 = g * 256;
    const bf16_t* VT = (const bf16_t*)(p.ws + O_VT);
    const float* VSS = (const float*)(p.ws + O_VSS);
    float* rstd = (float*)(lds + LDS_X);
    __syncthreads();
    if (tid < 128) {
        const f32x4* q = (const f32x4*)(VSS + (size_t)(m0 + tid) * 16);
        const f32x4 a = q[0] + q[1] + q[2] + q[3];
        rstd[tid] = __builtin_amdgcn_rsqf((a[0] + a[1] + a[2] + a[3]) * (1.f / 1024.f) + EPS);
    }
    stage_half<4>(lds + 32768, VT + (size_t)c0 * R + m0, R, tid);
    stage_half<4>(lds + 65536, VT + (size_t)c0 * R + m0 + 64, R, tid);
    __syncthreads();
    const float* ws = p.in[13] + (size_t)(l * 4 + g) * 128 * 128;
#pragma unroll
    for (int t = 0; t < 2; ++t)
#pragma unroll
        for (int i = 0; i < 2; ++i) {
            const int b = tid * 16 + i * 8192; int r, c; stage_rc(b, r, c);
            const f32x4 v0 = *(const f32x4*)(ws + r * 128 + t * 64 + c), v1 = *(const f32x4*)(ws + r * 128 + t * 64 + c + 4);
            const float* rs = rstd + t * 64 + c;
            u32x4 w; w.x = pk(v0[0] * rs[0], v0[1] * rs[1]); w.y = pk(v0[2] * rs[2], v0[3] * rs[3]); w.z = pk(v1[0] * rs[4], v1[1] * rs[5]); w.w = pk(v1[2] * rs[6], v1[3] * rs[7]);
            *(u32x4*)(lds + t * 16384 + b) = w;
        }
    WAIT_VM0();
    __syncthreads();
    f32x4 acc[4][4];
#pragma unroll
    for (int m = 0; m < 4; ++m)
#pragma unroll
        for (int n = 0; n < 4; ++n) acc[m][n] = (f32x4){0.f, 0.f, 0.f, 0.f};
    { const unsigned la = lds_addr(lds) + lds_byte(wr * 64 + fr, fq * 8), lb = lds_addr(lds) + 32768 + lds_byte(wc * 64 + fr, fq * 8);
      compute_ktile<4>(la, lb, acc);
      compute_ktile<4>(la + 16384, lb + 32768, acc); }
    const bf16_t* U = (const bf16_t*)(p.ws + O_U);
    bf16_t* ABR = (bf16_t*)(p.ws + O_ABR);
    const float* gain = p.in[12] + (size_t)l * D;
    const float* bs = p.in[14] + (size_t)(l * 4 + g) * 128;
#pragma unroll
    for (int m = 0; m < 4; ++m) {
        const int pr = wr * 64 + m * 16 + fr;
        const float bias = bs[pr];
#pragma unroll
        for (int n = 0; n < 4; ++n) {
            const int col = c0 + wc * 64 + n * 16 + fq * 4;
            const f32x4 gn = *(const f32x4*)(gain + col);
            const u32x2 uv = *(const u32x2*)(U + (size_t)(m0 + pr) * D + col);
            f32x4 u; u[0] = __uint_as_float(uv.x << 16); u[1] = __uint_as_float(uv.x & 0xffff0000u); u[2] = __uint_as_float(uv.y << 16); u[3] = __uint_as_float(uv.y & 0xffff0000u);
            store_bf4(ABR + (size_t)(m0 + pr) * D + col, u * (gn * acc[m][n] + bias));
        }
    }
}

__device__ void attn_item(const Params& p, int l, bool ctx, int b, int h, int qt, unsigned char* lds) {
    const int tid = otid(), wid = tid >> 6, lane = tid & 63, fr = lane & 15, fq = lane >> 4;
    const int qrow0 = (ctx ? b * 256 : RC + b * 1024) + qt * 128 + wid * 16;
    const bf16_t* Kb = ctx ? (const bf16_t*)(p.ws + O_KC) + (size_t)(b * 256) * 1024 + h * 128
                           : (const bf16_t*)(p.ws + O_KL) + ((size_t)(l * 2 + b) * 1280) * 1024 + h * 128;
    const int ldv = ctx ? 256 : 1280;
    const bf16_t* Vb = ctx ? (const bf16_t*)(p.ws + O_VTC) + ((size_t)(b * 8 + h) * 128) * 256
                           : (const bf16_t*)(p.ws + O_VTL) + ((size_t)((l * 2 + b) * 8 + h) * 128) * 1280;
    const int nt = ctx ? 4 : 20;
    const float* lp = p.in[15] + (size_t)l * 256;
    float e1 = lp[lane] * lp[64 + lane], e2 = lp[128 + lane] * lp[192 + lane];
#pragma unroll
    for (int o = 32; o >= 1; o >>= 1) { e1 += __shfl_xor(e1, o); e2 += __shfl_xor(e2, o); }
    const float lam_init = 0.8f - 0.6f * fexp(-0.3f * (float)l);
    const float lam = fexp(e1) - fexp(e2) + lam_init;
    const bf16_t* Q = (const bf16_t*)(p.ws + O_Q) + (size_t)(qrow0 + fr) * 1024 + h * 128;
    bf16x8 qf[2][2];
#pragma unroll
    for (int i2 = 0; i2 < 2; ++i2)
#pragma unroll
        for (int ks = 0; ks < 2; ++ks) qf[i2][ks] = *(const bf16x8*)(Q + i2 * 64 + ks * 32 + fq * 8);
    f32x4 O1[8], O2[8];
#pragma unroll
    for (int e = 0; e < 8; ++e) { O1[e] = (f32x4){0.f, 0.f, 0.f, 0.f}; O2[e] = O1[e]; }
    float mrun[2] = {-1e30f, -1e30f}, lsum[2] = {0.f, 0.f};

    __syncthreads();
#define STAGE_KV(s, t)                                                                                             \
    do {                                                                                                           \
        _Pragma("unroll") for (int i = 0; i < 2; ++i) {                                                            \
            const int P = tid + i * 512;                                                                           \
            const int key = P >> 4, c = (P & 15) ^ (key & 15);                                                     \
            glds16(Kb + (size_t)((t) * 64 + key) * 1024 + c * 8, lds + (s) * 32768 + P * 16);                      \
        }                                                                                                          \
        _Pragma("unroll") for (int i = 0; i < 2; ++i) {                                                            \
            const int P = tid + i * 512;                                                                           \
            const int e = P >> 3, c = (P & 7) ^ ((e >> 1) & 7);                                                    \
            glds16(Vb + (size_t)e * ldv + (t) * 64 + c * 8, lds + (s) * 32768 + 16384 + P * 16);                   \
        }                                                                                                          \
    } while (0)
    unsigned aK[2][2], aV[2][2];
    {
        const unsigned lb0 = lds_addr(lds), sw = (unsigned)(fr >> 1) & 7u;
#pragma unroll
        for (int i2 = 0; i2 < 2; ++i2)
#pragma unroll
            for (int ks = 0; ks < 2; ++ks) aK[i2][ks] = lb0 + fr * 256 + ((((unsigned)(i2 * 8 + ks * 4 + fq)) ^ (unsigned)fr) << 4);
#pragma unroll
        for (int kk = 0; kk < 2; ++kk)
#pragma unroll
            for (int h2 = 0; h2 < 2; ++h2) aV[kk][h2] = lb0 + 16384 + fr * 128 + ((((unsigned)(kk * 4 + (fq >> 1) + 2 * h2)) ^ sw) << 4) + (fq & 1) * 8;
    }
#define LDS_RD64(dst, base, off) asm volatile("ds_read_b64 %0, %1 offset:" #off : "=v"(dst) : "v"(base) : "memory")
    STAGE_KV(0, 0); STAGE_KV(1, 1);
    int cur = 0, nxt = 2;
    for (int t = 0; t < nt; ++t) {
        if (t + 1 < nt) asm volatile("s_waitcnt vmcnt(4)" ::: "memory"); else asm volatile("s_waitcnt vmcnt(0)" ::: "memory");
        __builtin_amdgcn_sched_barrier(0);
        asm volatile("" ::: "memory");
        __builtin_amdgcn_s_barrier();
        asm volatile("" ::: "memory");
        __builtin_amdgcn_sched_barrier(0);
        if (t + 2 < nt) STAGE_KV(nxt, t + 2);
        const unsigned off = (unsigned)cur * 32768u;
        cur = (cur == 2) ? 0 : cur + 1; nxt = (nxt == 2) ? 0 : nxt + 1;
        f32x4 s[2][4];
        {
            bf16x8 kf[2][4][2];
            const unsigned k00 = aK[0][0] + off, k01 = aK[0][1] + off, k10 = aK[1][0] + off, k11 = aK[1][1] + off;
            LDS_RD(kf[0][0][0], k00, 0); LDS_RD(kf[0][0][1], k01, 0); LDS_RD(kf[0][1][0], k00, 4096); LDS_RD(kf[0][1][1], k01, 4096);
            LDS_RD(kf[0][2][0], k00, 8192); LDS_RD(kf[0][2][1], k01, 8192); LDS_RD(kf[0][3][0], k00, 12288); LDS_RD(kf[0][3][1], k01, 12288);
            LDS_RD(kf[1][0][0], k10, 0); LDS_RD(kf[1][0][1], k11, 0); LDS_RD(kf[1][1][0], k10, 4096); LDS_RD(kf[1][1][1], k11, 4096);
            LDS_RD(kf[1][2][0], k10, 8192); LDS_RD(kf[1][2][1], k11, 8192); LDS_RD(kf[1][3][0], k10, 12288); LDS_RD(kf[1][3][1], k11, 12288);
            __builtin_amdgcn_sched_barrier(0);
            asm volatile("s_waitcnt lgkmcnt(8)" ::: "memory");
            __builtin_amdgcn_sched_barrier(0);
#pragma unroll
            for (int kt = 0; kt < 4; ++kt) {
                s[0][kt] = __builtin_amdgcn_mfma_f32_16x16x32_bf16(kf[0][kt][0], qf[0][0], (f32x4){0.f, 0.f, 0.f, 0.f}, 0, 0, 0);
                s[0][kt] = __builtin_amdgcn_mfma_f32_16x16x32_bf16(kf[0][kt][1], qf[0][1], s[0][kt], 0, 0, 0);
            }
            __builtin_amdgcn_sched_barrier(0);
            asm volatile("s_waitcnt lgkmcnt(0)" ::: "memory");
            __builtin_amdgcn_sched_barrier(0);
#pragma unroll
            for (int kt = 0; kt < 4; ++kt) {
                s[1][kt] = __builtin_amdgcn_mfma_f32_16x16x32_bf16(kf[1][kt][0], qf[1][0], (f32x4){0.f, 0.f, 0.f, 0.f}, 0, 0, 0);
                s[1][kt] = __builtin_amdgcn_mfma_f32_16x16x32_bf16(kf[1][kt][1], qf[1][1], s[1][kt], 0, 0, 0);
            }
            __builtin_amdgcn_sched_barrier(0);
        }
        bf16x8 pf[2][2];
#pragma unroll
        for (int i2 = 0; i2 < 2; ++i2) {
            float mx = -1e30f;
#pragma unroll
            for (int kt = 0; kt < 4; ++kt)
#pragma unroll
                for (int j = 0; j < 4; ++j) mx = fmaxf(mx, s[i2][kt][j]);
            if (__builtin_amdgcn_ballot_w64(mx > mrun[i2] + 8.f) != 0) {
                mx = fmaxf(mx, __shfl_xor(mx, 16)); mx = fmaxf(mx, __shfl_xor(mx, 32));
                const float mn = fmaxf(mrun[i2], mx);
                const float alpha = fexp2(mrun[i2] - mn);
                mrun[i2] = mn;
                lsum[i2] *= alpha;
                if (i2 == 0) {
#pragma unroll
                    for (int e = 0; e < 8; ++e) O1[e] = O1[e] * alpha;
                } else {
#pragma unroll
                    for (int e = 0; e < 8; ++e) O2[e] = O2[e] * alpha;
                }
            }
            const float mn = mrun[i2];
            float ps = 0.f;
#pragma unroll
            for (int kt = 0; kt < 4; ++kt)
#pragma unroll
                for (int j = 0; j < 4; ++j) { const float pv = fexp2(s[i2][kt][j] - mn); s[i2][kt][j] = pv; ps += pv; }
            lsum[i2] += ps;
#pragma unroll
            for (int kk = 0; kk < 2; ++kk) {
                u32x4 w;
                w.x = pk(s[i2][2 * kk][0], s[i2][2 * kk][1]); w.y = pk(s[i2][2 * kk][2], s[i2][2 * kk][3]);
                w.z = pk(s[i2][2 * kk + 1][0], s[i2][2 * kk + 1][1]); w.w = pk(s[i2][2 * kk + 1][2], s[i2][2 * kk + 1][3]);
                pf[i2][kk] = __builtin_bit_cast(bf16x8, w);
            }
        }
        {
            const unsigned v00 = aV[0][0] + off, v01 = aV[0][1] + off, v10 = aV[1][0] + off, v11 = aV[1][1] + off;
            u32x2 vl[8][2], vh[8][2];
#define RDV(et, o) do { LDS_RD64(vl[et][0], v00, o); LDS_RD64(vh[et][0], v01, o); LDS_RD64(vl[et][1], v10, o); LDS_RD64(vh[et][1], v11, o); } while (0)
#define PV_STEP(et, WAITN) do { __builtin_amdgcn_sched_barrier(0); asm volatile("s_waitcnt lgkmcnt(" #WAITN ")" ::: "memory"); __builtin_amdgcn_sched_barrier(0); \
            _Pragma("unroll") for (int kk = 0; kk < 2; ++kk) { u32x4 w; w.x = vl[et][kk].x; w.y = vl[et][kk].y; w.z = vh[et][kk].x; w.w = vh[et][kk].y; \
                const bf16x8 vf = __builtin_bit_cast(bf16x8, w); \
                O1[et] = __builtin_amdgcn_mfma_f32_16x16x32_bf16(vf, pf[0][kk], O1[et], 0, 0, 0); O2[et] = __builtin_amdgcn_mfma_f32_16x16x32_bf16(vf, pf[1][kk], O2[et], 0, 0, 0); } \
            __builtin_amdgcn_sched_barrier(0); } while (0)
            RDV(0, 0); RDV(1, 2048); RDV(2, 4096);
            PV_STEP(0, 8); RDV(3, 6144);
            PV_STEP(1, 8); RDV(4, 8192);
            PV_STEP(2, 8); RDV(5, 10240);
            PV_STEP(3, 8); RDV(6, 12288);
            PV_STEP(4, 8); RDV(7, 14336);
            PV_STEP(5, 8);
            PV_STEP(6, 4);
            PV_STEP(7, 0);
#undef PV_STEP
#undef RDV
        }
    }
#undef STAGE_KV
    float l1 = lsum[0], l2 = lsum[1];
    l1 += __shfl_xor(l1, 16); l1 += __shfl_xor(l1, 32);
    l2 += __shfl_xor(l2, 16); l2 += __shfl_xor(l2, 32);
    const float i1 = 1.f / l1, i2s = lam / l2;
    float ss = 0.f;
#pragma unroll
    for (int e = 0; e < 8; ++e) {
        O1[e] = O1[e] * i1 - O2[e] * i2s;
        ss += O1[e][0] * O1[e][0] + O1[e][1] * O1[e][1] + O1[e][2] * O1[e][2] + O1[e][3] * O1[e][3];
    }
    ss += __shfl_xor(ss, 16); ss += __shfl_xor(ss, 32);
    const float rn = __builtin_amdgcn_rsqf(ss * (1.f / 128.f) + EPS) * (1.f - lam_init);
    const float* sg = p.in[16] + (size_t)l * 128;
    bf16_t* BBR = (bf16_t*)(p.ws + O_BBR) + (size_t)(qrow0 + fr) * 1024 + h * 128;
#pragma unroll
    for (int e = 0; e < 8; ++e) {
        const f32x4 gn = *(const f32x4*)(sg + e * 16 + fq * 4);
        store_bf4(BBR + e * 16 + fq * 4, O1[e] * rn * gn);
    }
}

__device__ void phase_mix(const Params& p, int l, unsigned char* lds) {
    constexpr int NQ = 16 + 32 + 24;
    unsigned* ctr = (unsigned*)(p.ws + O_BAR + 14336) + l * 128;
    volatile int* slot = (volatile int*)(lds + LDS_X + 528);
    const int x0 = (int)blockIdx.x & 7;
    for (int dq = 0; dq < 8; ++dq) {
        const int q = (x0 + dq) & 7;
        for (;;) {
            __syncthreads();
            if (threadIdx.x == 0) *slot = (int)__hip_atomic_fetch_add(ctr + q * 16, 1u, __ATOMIC_RELAXED, __HIP_MEMORY_SCOPE_AGENT);
            __syncthreads();
            const int k = *slot;
            if (k >= NQ) break;
            if (k < 16) attn_item(p, l, false, k >> 3, q, k & 7, lds);
            else if (k < 48) attn_item(p, l, true, (k - 16) >> 1, q, (k - 16) & 1, lds);
            else spatial_item(p, l, q * 24 + (k - 48), lds);
        }
    }
}

#define XB_TMO      128
#define XB_XCNT(j)  (256  + 64 * (j))
#define XB_XSUB(j)  (1280 + 64 * (j))
#define XB_XGEN(j)  (2304 + 64 * (j))
#define XB_TOP      3328
#define XB_TOPGEN   3392
#define XCD_BAR_WORDS 3456
#define XB_SPIN_CAP (1u << 18)
#define LAS __attribute__((address_space(3)))

__device__ __forceinline__ unsigned xb_ld(unsigned* p)              { return __hip_atomic_load(p, __ATOMIC_RELAXED, __HIP_MEMORY_SCOPE_AGENT); }
__device__ __forceinline__ unsigned xb_add(unsigned* p, unsigned v) { return __hip_atomic_fetch_add(p, v, __ATOMIC_RELAXED, __HIP_MEMORY_SCOPE_AGENT); }
__device__ __forceinline__ unsigned xb_xcc_id() { return (unsigned)__builtin_amdgcn_s_getreg((3 << 11) | 20) & 0xFu; }
#define XB_SPIN(cond, bar) do { unsigned _sp = 0; while (cond) { __builtin_amdgcn_s_sleep(1); \
    if ((++_sp & 255u) == 0u) { if (xb_ld(&(bar)[XB_TMO])) break; if (_sp > XB_SPIN_CAP) { atomicAdd(&(bar)[XB_TMO], 1u); break; } } } } while (0)

struct XcdBarrier {
    unsigned* bar; unsigned x;
    volatile LAS unsigned* st;
};

__device__ __forceinline__ XcdBarrier xcd_barrier_post(unsigned* bar, volatile LAS unsigned* st) {
    XcdBarrier b; b.bar = bar; b.x = xb_xcc_id(); b.st = st;
    if (threadIdx.x == 0) (void)xb_add(&bar[XB_XCNT(b.x)], 1u);
    return b;
}
__device__ __forceinline__ void xcd_barrier_complete(unsigned* bar, unsigned x, unsigned& nloc, unsigned& nx) {
    const unsigned G = gridDim.x * gridDim.y * gridDim.z;
    unsigned sum, cnt, mine, sp = 0u;
    for (;;) {
        sum = 0u; cnt = 0u; mine = 0u;
#pragma unroll
        for (unsigned j = 0; j < 16; ++j) { const unsigned c = xb_ld(&bar[XB_XCNT(j)]); sum += c; cnt += (c > 0u) ? 1u : 0u; mine = (j == x) ? c : mine; }
        if (sum == G) break;
        __builtin_amdgcn_s_sleep(1);
        if ((++sp & 255u) == 0u) { if (xb_ld(&bar[XB_TMO])) break; if (sp > XB_SPIN_CAP) { atomicAdd(&bar[XB_TMO], 1u); break; } }
    }
    nloc = mine > 0u ? mine : 1u; nx = cnt > 0u ? cnt : 1u;
}

__device__ __forceinline__ void xcd_barrier(const XcdBarrier& b) {
    asm volatile("s_waitcnt vmcnt(0)" ::: "memory");
    __syncthreads();
    if (threadIdx.x == 0) {
        unsigned* bar = b.bar;
        __builtin_amdgcn_s_waitcnt(0);
        unsigned nloc = b.st[0], nx = b.st[1];
        if (nloc == 0u) { xcd_barrier_complete(bar, b.x, nloc, nx); b.st[0] = nloc; b.st[1] = nx; }
        const unsigned old = xb_add(&bar[XB_XSUB(b.x)], 1u);
        const unsigned gen = old / nloc;
        if (old + 1u == (gen + 1u) * nloc) {
            __builtin_amdgcn_fence(__ATOMIC_RELEASE, "agent");
            asm volatile("s_waitcnt vmcnt(0)" ::: "memory");
            const unsigned og = xb_add(&bar[XB_TOP], 1u);
            const unsigned tg = og / nx;
            if (og + 1u == (tg + 1u) * nx) xb_add(&bar[XB_TOPGEN], 1u);
            else XB_SPIN(xb_ld(&bar[XB_TOPGEN]) == tg, bar);
            __builtin_amdgcn_fence(__ATOMIC_ACQUIRE, "agent");
            xb_add(&bar[XB_XGEN(b.x)], 1u);
            asm volatile("s_waitcnt vmcnt(0)" ::: "memory");
        } else {
            XB_SPIN(xb_ld(&bar[XB_XGEN(b.x)]) == gen, bar);
            __builtin_amdgcn_fence(__ATOMIC_ACQUIRE, "agent");
            asm volatile("s_waitcnt vmcnt(0)" ::: "memory");
        }
    }
    __syncthreads();
}


constexpr int NPHASE = 46;
__device__ void run_phase(const Params& p, int ph, unsigned char* lds) {
    if (ph == 0) { phase_prologue(p, lds); return; }
    if (ph == NPHASE - 1) { phase_norm(p, 0, 3); return; }
    const int l = (ph - 1) / 11, s = (ph - 1) % 11;
    switch (s) {
        case 0: phase_norm(p, l, 0); break;
        case 1: phase_gemm<G_UP>(p, l, 0, lds); break;
        case 2: phase_gemm<G_DOWN>(p, l, 0, lds); break;
        case 3: phase_norm(p, l, 1); break;
        case 4: phase_gemm<G_WIN>(p, l, 0, lds); break;
        case 5: phase_mix(p, l, lds); break;
        case 6: phase_gemm<G_BR>(p, l, 0, lds); break;
        case 7: phase_gemm<G_OUT>(p, l, 0, lds); break;
        case 8: phase_norm(p, l, 2); break;
        case 9: phase_gemm<G_UP>(p, l, 1, lds); break;
        default: phase_gemm<G_DOWN>(p, l, 1, lds); break;
    }
}

__global__ void __launch_bounds__(NTHR, 2) fwd_kernel(Params p) {
    extern __shared__ __attribute__((aligned(16))) unsigned char lds[];
#if COOP
    cg::grid_group grid = cg::this_grid();
    volatile LAS unsigned* st = (volatile LAS unsigned*)(lds + LDS_X + 512);
    if (threadIdx.x == 0) { st[0] = 0u; st[1] = 0u; st[2] = 0u; st[3] = 0u; }
    __syncthreads();
    XcdBarrier xb = xcd_barrier_post((unsigned*)(p.ws + O_BAR), st);
    for (int ph = p.ph_lo; ph < p.ph_hi; ++ph) {
#ifdef PROBE_DUP
        { const int s_ = (ph == 0) ? 16 : (ph == NPHASE - 1 ? 17 : (ph - 1) % 11);
          const int nrep = ((PROBE_DUP >> s_) & 1) ? 2 : 1;
          for (int rep = 0; rep < nrep; ++rep) { if (rep) xcd_barrier(xb); run_phase(p, ph, lds); }
          if ((PROBE_DUP >> 20) & 1) { xcd_barrier(xb); } }
#else
        run_phase(p, ph, lds);
#endif
        if (ph + 1 < p.ph_hi) { if (p.ph_lo < 0) grid.sync(); else xcd_barrier(xb); }
    }
#else
    for (int ph = p.ph_lo; ph < p.ph_hi; ++ph) run_phase(p, ph, lds);
#endif
}

extern "C" void kernel_launch(void* const* d_in, const int* in_sizes, int n_in, void* d_out, int out_size, void* d_ws, size_t ws_size, hipStream_t stream) {
    static int grid_blocks = 0;
    if (!grid_blocks) {
        int dev = 0, cus = 0, per_cu = 0;
        hipGetDevice(&dev);
        hipDeviceGetAttribute(&cus, hipDeviceAttributeMultiprocessorCount, dev);
        hipFuncSetAttribute((const void*)fwd_kernel, hipFuncAttributeMaxDynamicSharedMemorySize, LDS_BYTES);
        hipOccupancyMaxActiveBlocksPerMultiprocessor(&per_cu, (const void*)fwd_kernel, NTHR, LDS_BYTES);
        if (per_cu < 1) per_cu = 1;
        if (per_cu > 1) per_cu = 1;
        grid_blocks = cus * per_cu;
        if (n_in != 23 || ws_size < WS_END) fprintf(stderr, "kernel_launch: unexpected n_in %d or ws_size %zu (need %zu)\n", n_in, ws_size, (size_t)WS_END);
    }
    Params p{};
    for (int i = 0; i < 23; ++i) p.in[i] = (const float*)d_in[i];
    p.out = (float*)d_out; p.ws = (unsigned char*)d_ws;
#if COOP
    p.ph_lo = 0; p.ph_hi = NPHASE;
    (void)hipMemsetAsync((unsigned char*)d_ws + O_BAR, 0, 16384, stream);
    void* args[] = {&p};
    hipError_t e = hipLaunchCooperativeKernel((const void*)fwd_kernel, dim3(grid_blocks), dim3(NTHR), args, LDS_BYTES, stream);
    if (e != hipSuccess) fprintf(stderr, "cooperative launch failed: %s (grid %d)\n", hipGetErrorString(e), grid_blocks);
#else
    for (int ph = 0; ph < NPHASE; ++ph) {
        p.ph_lo = ph; p.ph_hi = ph + 1;
        hipLaunchKernelGGL(fwd_kernel, dim3(grid_blocks), dim3(NTHR), LDS_BYTES, stream, p);
    }
#endif
}
```

```cpp
#include <hip/hip_runtime.h>
#include <hip/hip_cooperative_groups.h>
#include <cstdio>
#include <cstdint>
namespace cg = cooperative_groups;

#ifndef COOP
#define COOP 1
#endif

typedef unsigned short bf16_t;
typedef short bf16x8 __attribute__((ext_vector_type(8)));
typedef short s16x4 __attribute__((ext_vector_type(4)));
typedef float f32x4 __attribute__((ext_vector_type(4)));
typedef float f32x2 __attribute__((ext_vector_type(2)));
typedef __bf16 bf16x2_t __attribute__((ext_vector_type(2)));
typedef unsigned u32x2 __attribute__((ext_vector_type(2)));
typedef unsigned u32x4 __attribute__((ext_vector_type(4)));

#define DI __device__ __forceinline__

constexpr int R = 6144;
constexpr int RC = 4096;
constexpr int D = 1024;
constexpr int DFF = 2816;
constexpr int INW = 7168;
constexpr int NTHR = 512;
constexpr int LDS_X = 147456;
constexpr int LDS_BYTES = LDS_X + 1024;
constexpr float EPS = 1e-6f;

constexpr size_t al(size_t x) { return (x + 255) & ~(size_t)255; }
constexpr size_t O_X = 0;
constexpr size_t O_H = al(O_X + (size_t)R * D * 4);
constexpr size_t O_ACT = al(O_H + (size_t)R * D * 2);
constexpr size_t O_U = al(O_ACT + (size_t)R * DFF * 2);
constexpr size_t O_VT = al(O_U + (size_t)R * D * 2);
constexpr size_t O_VSS = al(O_VT + (size_t)R * D * 2);
constexpr size_t O_Q = al(O_VSS + (size_t)R * 16 * 4);
constexpr size_t O_KC = al(O_Q + (size_t)R * D * 2);
constexpr size_t O_KL = al(O_KC + (size_t)RC * D * 2);
constexpr size_t O_VTC = al(O_KL + (size_t)8 * 1280 * D * 2);
constexpr size_t O_VTL = al(O_VTC + (size_t)16 * 8 * 128 * 256 * 2);
constexpr size_t O_SG = al(O_VTL + (size_t)8 * 8 * 128 * 1280 * 2);
constexpr size_t O_ABR = al(O_SG + (size_t)R * 2048 * 2);
constexpr size_t O_BBR = al(O_ABR + (size_t)R * D * 2);
constexpr size_t O_MG = al(O_BBR + (size_t)R * D * 2);
constexpr size_t O_MG1 = al(O_MG + (size_t)R * D * 2);
constexpr size_t O_MOD = al(O_MG1 + (size_t)R * D * 4);
constexpr size_t O_ROPE = al(O_MOD + (size_t)4 * 3 * 9216 * 4);
constexpr size_t O_W = al(O_ROPE + 8192);
constexpr size_t WE_13A = 0;
constexpr size_t WE_2A = WE_13A + (size_t)5632 * 1024;
constexpr size_t WE_IN = WE_2A + (size_t)1024 * 2816;
constexpr size_t WE_A = WE_IN + (size_t)7168 * 1024;
constexpr size_t WE_B = WE_A + (size_t)1024 * 1024;
constexpr size_t WE_O = WE_B + (size_t)1024 * 1024;
constexpr size_t WE_13B = WE_O + (size_t)1024 * 1024;
constexpr size_t WE_2B = WE_13B + (size_t)5632 * 1024;
constexpr size_t WE_LAYER = WE_2B + (size_t)1024 * 2816;
constexpr size_t O_BAR = al(O_W + WE_LAYER * 4 * 2);
constexpr size_t WS_END = O_BAR + 16384;

struct Params {
    const float* in[23];
    float* out;
    unsigned char* ws;
    int ph_lo, ph_hi;
};

DI unsigned pk(float a, float b) { f32x2 v = {a, b}; bf16x2_t r = __builtin_convertvector(v, bf16x2_t); return __builtin_bit_cast(unsigned, r); }
DI float bf2f(bf16_t v) { return __uint_as_float(((unsigned)v) << 16); }
DI float bfround(float a) { unsigned u = pk(a, 0.f); return __uint_as_float(u << 16); }
DI float fexp2(float x) { return __builtin_amdgcn_exp2f(x); }
DI float fexp(float x) { return __builtin_amdgcn_exp2f(x * 1.44269504089f); }
DI float frcp(float x) { return __builtin_amdgcn_rcpf(x); }
DI float sigmoidf_(float x) { return frcp(1.f + fexp(-x)); }
DI float siluf_(float x) { return x * sigmoidf_(x); }
DI float geluf_(float x) { float u = 0.7978845608f * (x + 0.044715f * x * x * x); return x * frcp(1.f + fexp(-2.f * u)); }
DI int otid() { int t = threadIdx.x; asm volatile("" : "+v"(t)); return t; }
DI int cond_of_row(int row) { return row < RC ? 0 : 1 + ((row - RC) >> 10); }

DI int lds_byte(int r, int c) { const int st = (r >> 4) * 2 + (c >> 5), rr = r & 15, cc = c & 31, ob = rr * 64 + cc * 2; return st * 1024 + (ob ^ (((ob >> 9) & 1) << 5)); }
DI void stage_rc(int b, int& Rr, int& Cc) { const int st = b / 1024, sb = b % 1024, swz = sb ^ (((sb >> 9) & 1) << 5); Rr = (st >> 1) * 16 + swz / 64; Cc = (st & 1) * 32 + (swz % 64) / 2; }

DI void glds16(const void* g, void* l) { __builtin_amdgcn_global_load_lds((const unsigned*)g, (unsigned*)l, 16, 0, 0); }
#define WAIT_VM0() asm volatile("s_waitcnt vmcnt(0)" ::: "memory")

template <int NI = 4>
DI void stage_half(unsigned char* buf, const bf16_t* src, int ld, int tid) {
#pragma unroll
    for (int i = 0; i < NI; ++i) {
        const int b = tid * 16 + i * 8192; int r, c; stage_rc(b, r, c);
        glds16(src + (size_t)r * ld + c, buf + b);
    }
}

#define LDS_RD(dst, base, off) asm volatile("ds_read_b128 %0, %1 offset:" #off : "=v"(dst) : "v"(base) : "memory")
template <int MI>
DI void compute_ktile(unsigned sa, unsigned sb, f32x4 (&acc)[MI][4]) {
    bf16x8 af[2][4], bw[2][4];
    LDS_RD(af[0][0], sa, 0); if (MI > 1) LDS_RD(af[0][1], sa, 2048); if (MI > 2) LDS_RD(af[0][2], sa, 4096); if (MI > 3) LDS_RD(af[0][3], sa, 6144);
    LDS_RD(bw[0][0], sb, 0); LDS_RD(bw[0][1], sb, 2048); LDS_RD(bw[0][2], sb, 4096); LDS_RD(bw[0][3], sb, 6144);
    LDS_RD(af[1][0], sa, 1024); if (MI > 1) LDS_RD(af[1][1], sa, 3072); if (MI > 2) LDS_RD(af[1][2], sa, 5120); if (MI > 3) LDS_RD(af[1][3], sa, 7168);
    LDS_RD(bw[1][0], sb, 1024); LDS_RD(bw[1][1], sb, 3072); LDS_RD(bw[1][2], sb, 5120); LDS_RD(bw[1][3], sb, 7168);
    __builtin_amdgcn_sched_barrier(0);
    if (MI == 4) asm volatile("s_waitcnt lgkmcnt(8)" ::: "memory"); else if (MI == 3) asm volatile("s_waitcnt lgkmcnt(7)" ::: "memory"); else if (MI == 2) asm volatile("s_waitcnt lgkmcnt(6)" ::: "memory"); else asm volatile("s_waitcnt lgkmcnt(5)" ::: "memory");
    __builtin_amdgcn_sched_barrier(0);
#pragma unroll
    for (int m = 0; m < MI; ++m)
#pragma unroll
        for (int n = 0; n < 4; ++n) acc[m][n] = __builtin_amdgcn_mfma_f32_16x16x32_bf16(bw[0][n], af[0][m], acc[m][n], 0, 0, 0);
    __builtin_amdgcn_sched_barrier(0);
    asm volatile("s_waitcnt lgkmcnt(0)" ::: "memory");
    __builtin_amdgcn_sched_barrier(0);
#pragma unroll
    for (int m = 0; m < MI; ++m)
#pragma unroll
        for (int n = 0; n < 4; ++n) acc[m][n] = __builtin_amdgcn_mfma_f32_16x16x32_bf16(bw[1][n], af[1][m], acc[m][n], 0, 0, 0);
    __builtin_amdgcn_sched_barrier(0);
}
DI unsigned lds_addr(const void* p) { return (unsigned)(uintptr_t)(const __attribute__((address_space(3))) unsigned char*)p; }

template <int MI>
DI void gemm_tile(const bf16_t* A, int lda, const bf16_t* Bt, int ldb, int K, int m0, int n0, f32x4 (&acc)[MI][4], unsigned char* lds) {
    const int tid = otid(), wid = tid >> 6, lane = tid & 63, wr = wid >> 1, wc = wid & 1, fr = lane & 15, fq = lane >> 4;
#pragma unroll
    for (int m = 0; m < MI; ++m)
#pragma unroll
        for (int n = 0; n < 4; ++n) acc[m][n] = (f32x4){0.f, 0.f, 0.f, 0.f};
    const bf16_t* Ab = A + (size_t)m0 * lda;
    const bf16_t* Bb = Bt + (size_t)n0 * ldb;
    const int nt = K >> 6;
    const unsigned la = lds_addr(lds) + lds_byte(wr * (MI * 16) + fr, fq * 8), lb = lds_addr(lds) + 32768 + lds_byte(wc * 64 + fr, fq * 8);
    __syncthreads();
    stage_half<MI>(lds, Ab, lda, tid);
    stage_half<2>(lds + 32768, Bb, ldb, tid);
    stage_half<MI>(lds + 49152, Ab + 64, lda, tid);
    stage_half<2>(lds + 49152 + 32768, Bb + 64, ldb, tid);
    int cur = 0, nxt = 2;
    for (int t = 0; t < nt; ++t) {
        if (t + 1 < nt) { if (MI == 4) asm volatile("s_waitcnt vmcnt(6)" ::: "memory"); else if (MI == 3) asm volatile("s_waitcnt vmcnt(5)" ::: "memory"); else if (MI == 2) asm volatile("s_waitcnt vmcnt(4)" ::: "memory"); else asm volatile("s_waitcnt vmcnt(3)" ::: "memory"); }
        else asm volatile("s_waitcnt vmcnt(0)" ::: "memory");
        __builtin_amdgcn_sched_barrier(0);
        asm volatile("" ::: "memory");
        __builtin_amdgcn_s_barrier();
        asm volatile("" ::: "memory");
        __builtin_amdgcn_sched_barrier(0);
        if (t + 2 < nt) {
            stage_half<MI>(lds + nxt * 49152, Ab + (t + 2) * 64, lda, tid);
            stage_half<2>(lds + nxt * 49152 + 32768, Bb + (t + 2) * 64, ldb, tid);
        }
        compute_ktile<MI>(la + cur * 49152, lb + cur * 49152, acc);
        cur = (cur == 2) ? 0 : cur + 1; nxt = (nxt == 2) ? 0 : nxt + 1;
    }
}

DI void store_bf4(bf16_t* p, f32x4 v) { u32x2 w; w.x = pk(v[0], v[1]); w.y = pk(v[2], v[3]); *(u32x2*)p = w; }

DI void transpose_tile(const float* __restrict__ src, int ld_src, bf16_t* __restrict__ dst, int ld_dst, int k0, int r0, int perm, float* tile_base) {
    const int tid = otid(), lt = tid & 255;
    float* tile = tile_base + (tid >> 8) * (64 * 65);
    const int ty = lt >> 4, tx = lt & 15, nn = tx * 4;
    const int scol = perm ? ((nn >> 5) * DFF + (r0 >> 7) * 64 + ((r0 >> 6) & 1) * 32 + (nn & 31)) : (r0 + nn);
    __syncthreads();
#pragma unroll
    for (int i = 0; i < 4; ++i) {
        const int kk = ty + 16 * i;
        const f32x4 v = __builtin_nontemporal_load((const f32x4*)(src + (size_t)(k0 + kk) * ld_src + scol));
        tile[kk * 65 + nn + 0] = v[0]; tile[kk * 65 + nn + 1] = v[1]; tile[kk * 65 + nn + 2] = v[2]; tile[kk * 65 + nn + 3] = v[3];
    }
    __syncthreads();
    const int n = lt >> 2, kc = lt & 3;
    u32x4 w0, w1;
    w0.x = pk(tile[(kc * 16 + 0) * 65 + n], tile[(kc * 16 + 1) * 65 + n]);
    w0.y = pk(tile[(kc * 16 + 2) * 65 + n], tile[(kc * 16 + 3) * 65 + n]);
    w0.z = pk(tile[(kc * 16 + 4) * 65 + n], tile[(kc * 16 + 5) * 65 + n]);
    w0.w = pk(tile[(kc * 16 + 6) * 65 + n], tile[(kc * 16 + 7) * 65 + n]);
    w1.x = pk(tile[(kc * 16 + 8) * 65 + n], tile[(kc * 16 + 9) * 65 + n]);
    w1.y = pk(tile[(kc * 16 + 10) * 65 + n], tile[(kc * 16 + 11) * 65 + n]);
    w1.z = pk(tile[(kc * 16 + 12) * 65 + n], tile[(kc * 16 + 13) * 65 + n]);
    w1.w = pk(tile[(kc * 16 + 14) * 65 + n], tile[(kc * 16 + 15) * 65 + n]);
    u32x4* d = (u32x4*)(dst + (size_t)(r0 + n) * ld_dst + k0 + kc * 16);
    d[0] = w0; d[1] = w1;
}

__device__ void phase_prologue(const Params& p, unsigned char* lds) {
    const int tid = otid();
    float* tile = (float*)lds;
    bf16_t* W = (bf16_t*)(p.ws + O_W);
    constexpr int NT_W = 27136 / 2, NT_MOD = 576, NT_CK = 512, NT_CV = 512 / 2, NT_X = 768;
    constexpr int TOTAL = NT_W + NT_MOD + NT_CK + NT_CV + NT_X + 1;
    for (int it = blockIdx.x; it < TOTAL; it += gridDim.x) {
        if (it < NT_W) {
            const int it2 = it * 2 + (tid >> 8);
            const int l = it2 / 6784, r = it2 % 6784;
            int widx, ti;
            if (r < 1408) { widx = 0; ti = r; } else if (r < 2112) { widx = 1; ti = r - 1408; } else if (r < 3904) { widx = 2; ti = r - 2112; }
            else if (r < 4160) { widx = 3; ti = r - 3904; } else if (r < 4416) { widx = 4; ti = r - 4160; } else if (r < 4672) { widx = 5; ti = r - 4416; }
            else if (r < 6080) { widx = 6; ti = r - 4672; } else { widx = 7; ti = r - 6080; }
            const float* src; int K, N, perm = 0; size_t we;
            switch (widx) {
                case 0: src = p.in[9]; K = 1024; N = 5632; perm = 1; we = WE_13A; break;
                case 1: src = p.in[10]; K = 2816; N = 1024; we = WE_2A; break;
                case 2: src = p.in[11]; K = 1024; N = 7168; we = WE_IN; break;
                case 3: src = p.in[17]; K = 1024; N = 1024; we = WE_A; break;
                case 4: src = p.in[18]; K = 1024; N = 1024; we = WE_B; break;
                case 5: src = p.in[19]; K = 1024; N = 1024; we = WE_O; break;
                case 6: src = p.in[20]; K = 1024; N = 5632; perm = 1; we = WE_13B; break;
                default: src = p.in[21]; K = 2816; N = 1024; we = WE_2B; break;
            }
            const int nkt = K >> 6;
            const int nrt = N >> 6;
            const int rt = ti % nrt, kt = ti / nrt;
            transpose_tile(src + (size_t)l * K * N, N, W + (size_t)l * WE_LAYER + we, K, kt * 64, rt * 64, perm, tile);
        } else if (it < NT_W + NT_MOD) {
            const int j = it - NT_W, l = j / 144, cb = j % 144;
            const int tx = tid & 15, kg = tid >> 4;
            const float* wm = p.in[6] + (size_t)l * 1024 * 9216 + cb * 64 + tx * 4;
            f32x4 a0 = {0.f, 0.f, 0.f, 0.f}, a1 = a0, a2 = a0;
#pragma unroll 8
            for (int k = kg; k < 1024; k += 32) {
                const f32x4 w = __builtin_nontemporal_load((const f32x4*)(wm + (size_t)k * 9216));
                const float s0 = siluf_(p.in[5][k]), s1 = siluf_(p.in[4][k]), s2 = siluf_(p.in[4][1024 + k]);
                a0 += w * s0; a1 += w * s1; a2 += w * s2;
            }
            __syncthreads();
            float* red = tile;
#pragma unroll
            for (int q = 0; q < 4; ++q) { red[(kg * 3 + 0) * 64 + tx * 4 + q] = a0[q]; red[(kg * 3 + 1) * 64 + tx * 4 + q] = a1[q]; red[(kg * 3 + 2) * 64 + tx * 4 + q] = a2[q]; }
            __syncthreads();
            if (tid < 192) {
                const int c = tid >> 6, col = tid & 63;
                float s = 0.f;
#pragma unroll
                for (int g = 0; g < 32; ++g) s += red[(g * 3 + c) * 64 + col];
                const int jc = cb * 64 + col;
                ((float*)(p.ws + O_MOD))[(size_t)(l * 3 + c) * 9216 + jc] = s + p.in[7][l * 9216 + jc];
            }
        } else if (it < NT_W + NT_MOD + NT_CK) {
            const int j = it - NT_W - NT_MOD;
            const size_t e0 = (size_t)j * 4096 + tid * 8;
            const int col = (int)(e0 & 1023), key = (int)((e0 >> 10) & 255), bl = (int)(e0 >> 18), b = bl >> 2, l = bl & 3;
            const f32x4 v0 = __builtin_nontemporal_load((const f32x4*)(p.in[2] + e0)), v1 = __builtin_nontemporal_load((const f32x4*)(p.in[2] + e0 + 4));
            u32x4 w; w.x = pk(v0[0], v0[1]); w.y = pk(v0[2], v0[3]); w.z = pk(v1[0], v1[1]); w.w = pk(v1[2], v1[3]);
            *(u32x4*)((bf16_t*)(p.ws + O_KL) + ((size_t)(l * 2 + b) * 1280 + key) * 1024 + col) = w;
        } else if (it < NT_W + NT_MOD + NT_CK + NT_CV) {
            const int j = (it - NT_W - NT_MOD - NT_CK) * 2 + (tid >> 8);
            const int et = j & 1, kt = (j >> 1) & 3, h = (j >> 3) & 7, l = (j >> 6) & 3, b = j >> 8;
            const float* src = p.in[3] + ((size_t)(b * 4 + l) * 256) * 1024 + h * 128;
            bf16_t* dst = (bf16_t*)(p.ws + O_VTL) + ((size_t)((l * 2 + b) * 8 + h) * 128) * 1280;
            transpose_tile(src, 1024, dst, 1280, kt * 64, et * 64, 0, tile);
        } else if (it == TOTAL - 1) {
            float* RT = (float*)(p.ws + O_ROPE);
#pragma unroll
            for (int i = 0; i < 2; ++i) {
                const int e = tid + i * 512, pos = e >> 4, fi = e & 15;
                const float ang = (float)pos * fexp2(-(float)fi * 0.8304820237f);
                float rev = ang * 0.15915494309f; rev -= floorf(rev);
                RT[e] = __builtin_amdgcn_cosf(rev); RT[1024 + e] = __builtin_amdgcn_sinf(rev);
            }
        } else {
            const int j = it - NT_W - NT_MOD - NT_CK - NT_CV;
            float* X = (float*)(p.ws + O_X);
#pragma unroll
            for (int i = 0; i < 4; ++i) {
                const size_t e = (size_t)j * 8192 + i * 2048 + tid * 4;
                const f32x4 v = (e < (size_t)RC * D) ? *(const f32x4*)(p.in[0] + e) : *(const f32x4*)(p.in[1] + (e - (size_t)RC * D));
                *(f32x4*)(X + e) = v;
            }
        }
    }
}

__device__ void phase_norm(const Params& p, int l, int which) {
    const int tid_ = otid(); const int lane = tid_ & 63, wid = tid_ >> 6;
    const float* X = (const float*)(p.ws + O_X);
    const float* MOD = (const float*)(p.ws + O_MOD);
    bf16_t* H = (bf16_t*)(p.ws + O_H);
    const bool affine = gridDim.x == 256;
    const int xg = (int)blockIdx.x & 7;
    const int gw = affine ? ((int)blockIdx.x >> 3) * 8 + wid : (int)blockIdx.x * 8 + wid, nw = affine ? 256 : (int)gridDim.x * 8;
    const int rend = affine ? 768 : R;
    for (int row0 = gw; row0 < rend; row0 += 3 * nw) {
        f32x4 v[3][4];
#pragma unroll
        for (int j = 0; j < 3; ++j) {
            int row = row0 + j * nw;
            if (affine) { const int rr = row0 + j * nw; row = (xg + 8 * (rr / 192)) * 192 + rr % 192; }
            if (row0 + j * nw < rend) {
#pragma unroll
                for (int i = 0; i < 4; ++i) v[j][i] = *(const f32x4*)(X + (size_t)row * D + i * 256 + lane * 4);
            }
        }
#pragma unroll
        for (int j = 0; j < 3; ++j) {
            int row = row0 + j * nw;
            if (affine) { const int rr = row0 + j * nw; row = (xg + 8 * (rr / 192)) * 192 + rr % 192; }
            if (row0 + j * nw < rend) {
                float ss = 0.f;
#pragma unroll
                for (int i = 0; i < 4; ++i) ss += v[j][i][0] * v[j][i][0] + v[j][i][1] * v[j][i][1] + v[j][i][2] * v[j][i][2] + v[j][i][3] * v[j][i][3];
#pragma unroll
                for (int o = 32; o >= 1; o >>= 1) ss += __shfl_xor(ss, o);
                const float r = __builtin_amdgcn_rsqf(ss * (1.f / 1024.f) + EPS);
                if (which < 3) {
                    const float* g = p.in[8] + (size_t)(l * 3 + which) * D;
                    const float* md = MOD + (size_t)(l * 3 + cond_of_row(row)) * 9216 + (size_t)(3 * which) * D;
#pragma unroll
                    for (int i = 0; i < 4; ++i) {
                        const int c = i * 256 + lane * 4;
                        const f32x4 gg = *(const f32x4*)(g + c), sh = *(const f32x4*)(md + c), sc = *(const f32x4*)(md + D + c);
                        store_bf4(H + (size_t)row * D + c, (v[j][i] * r) * gg * (sc + 1.f) + sh);
                    }
                } else {
#pragma unroll
                    for (int i = 0; i < 4; ++i) {
                        const int c = i * 256 + lane * 4;
                        *(f32x4*)(p.out + (size_t)row * D + c) = (v[j][i] * r) * (*(const f32x4*)(p.in[22] + c));
                    }
                }
            }
        }
    }
}

enum { G_UP = 0, G_DOWN = 1, G_WIN = 2, G_BR = 3, G_OUT = 4 };

template <int KIND, int MI>
DI void gemm_item(const Params& p, int l, int second, int m0, int ntile, unsigned char* lds) {
    const int tid = otid(), wid = tid >> 6, lane = tid & 63, wr = wid >> 1, wc = wid & 1, fr = lane & 15, fq = lane >> 4;
    const bf16_t* W = (const bf16_t*)(p.ws + O_W) + (size_t)l * WE_LAYER;
    const float* MOD = (const float*)(p.ws + O_MOD);
    float* X = (float*)(p.ws + O_X);
    const bf16_t* H = (const bf16_t*)(p.ws + O_H);
    bf16_t* ACT = (bf16_t*)(p.ws + O_ACT);
    constexpr int WMR = MI * 16;
    const int n0 = ntile * 128;
    {
        f32x4 acc[MI][4];
        if (KIND == G_UP) {
            gemm_tile<MI>(H, D, W + (second ? WE_13B : WE_13A), D, D, m0, n0, acc, lds);
#pragma unroll
            for (int m = 0; m < MI; ++m) {
                const int row = m0 + wr * WMR + m * 16 + fr;
#pragma unroll
                for (int nn = 0; nn < 2; ++nn) {
                    f32x4 o;
#pragma unroll
                    for (int j = 0; j < 4; ++j) o[j] = siluf_(acc[m][nn][j]) * acc[m][nn + 2][j];
                    store_bf4(ACT + (size_t)row * DFF + ntile * 64 + wc * 32 + nn * 16 + fq * 4, o);
                }
            }
        } else if (KIND == G_DOWN || KIND == G_OUT) {
            if (KIND == G_DOWN) gemm_tile<MI>(ACT, DFF, W + (second ? WE_2B : WE_2A), DFF, DFF, m0, n0, acc, lds);
            else gemm_tile<MI>((const bf16_t*)(p.ws + O_MG), D, W + WE_O, D, D, m0, n0, acc, lds);
            const int slot = (KIND == G_OUT) ? 5 : (second ? 8 : 2);
            const float scl = (KIND == G_OUT) ? 1.f : 0.5f;
#pragma unroll
            for (int m = 0; m < MI; ++m) {
                const int row = m0 + wr * WMR + m * 16 + fr;
                const float* gt = MOD + (size_t)(l * 3 + cond_of_row(row)) * 9216 + (size_t)slot * D;
#pragma unroll
                for (int n = 0; n < 4; ++n) {
                    const int col = n0 + wc * 64 + n * 16 + fq * 4;
                    const f32x4 g = *(const f32x4*)(gt + col) * scl;
                    f32x4* xp = (f32x4*)(X + (size_t)row * D + col);
                    *xp = *xp + g * acc[m][n];
                }
            }
        } else if (KIND == G_BR) {
            const bf16_t* SG = (const bf16_t*)(p.ws + O_SG);
            gemm_tile<MI>((const bf16_t*)(p.ws + O_ABR), D, W + WE_A, D, D, m0, n0, acc, lds);
            float* MG1 = (float*)(p.ws + O_MG1);
#pragma unroll
            for (int m = 0; m < MI; ++m) {
                const int row = m0 + wr * WMR + m * 16 + fr;
#pragma unroll
                for (int n = 0; n < 4; ++n) {
                    const int col = n0 + wc * 64 + n * 16 + fq * 4;
                    const u32x2 gv = *(const u32x2*)(SG + (size_t)row * 2048 + col);
                    f32x4 g; g[0] = __uint_as_float(gv.x << 16); g[1] = __uint_as_float(gv.x & 0xffff0000u); g[2] = __uint_as_float(gv.y << 16); g[3] = __uint_as_float(gv.y & 0xffff0000u);
                    *(f32x4*)(MG1 + (size_t)row * D + col) = g * acc[m][n];
                }
            }
            gemm_tile<MI>((const bf16_t*)(p.ws + O_BBR), D, W + WE_B, D, D, m0, n0, acc, lds);
            bf16_t* MG = (bf16_t*)(p.ws + O_MG);
#pragma unroll
            for (int m = 0; m < MI; ++m) {
                const int row = m0 + wr * WMR + m * 16 + fr;
#pragma unroll
                for (int n = 0; n < 4; ++n) {
                    const int col = n0 + wc * 64 + n * 16 + fq * 4;
                    const u32x2 gv = *(const u32x2*)(SG + (size_t)row * 2048 + 1024 + col);
                    f32x4 g; g[0] = __uint_as_float(gv.x << 16); g[1] = __uint_as_float(gv.x & 0xffff0000u); g[2] = __uint_as_float(gv.y << 16); g[3] = __uint_as_float(gv.y & 0xffff0000u);
                    const f32x4 m1 = *(const f32x4*)(MG1 + (size_t)row * D + col);
                    store_bf4(MG + (size_t)row * D + col, m1 + g * acc[m][n]);
                }
            }
        } else {
            gemm_tile<MI>(H, D, W + WE_IN, D, D, m0, n0, acc, lds);
            const bool ctx = m0 < RC;
            const int b = ctx ? (m0 >> 8) : ((m0 - RC) >> 10);
            const int pos0 = (ctx ? (m0 & 255) : ((m0 - RC) & 1023)) + wr * WMR;
            if (n0 < 1024) {
                bf16_t* U = (bf16_t*)(p.ws + O_U);
#pragma unroll
                for (int m = 0; m < MI; ++m)
#pragma unroll
                    for (int n = 0; n < 4; ++n) {
                        f32x4 o;
#pragma unroll
                        for (int j = 0; j < 4; ++j) o[j] = geluf_(acc[m][n][j]);
                        store_bf4(U + (size_t)(m0 + wr * WMR + m * 16 + fr) * D + n0 + wc * 64 + n * 16 + fq * 4, o);
                    }
            } else if (n0 < 2048) {
                bf16_t* VT = (bf16_t*)(p.ws + O_VT);
                float* VSS = (float*)(p.ws + O_VSS);
#pragma unroll
                for (int m = 0; m < MI; ++m) {
                    const int row = m0 + wr * WMR + m * 16 + fr;
                    float ss = 0.f;
#pragma unroll
                    for (int n = 0; n < 4; ++n)
#pragma unroll
                        for (int j = 0; j < 4; ++j) {
                            const float gq = bfround(geluf_(acc[m][n][j]));
                            ss += gq * gq;
                            const int ch = n0 - 1024 + wc * 64 + n * 16 + fq * 4 + j;
                            VT[(size_t)ch * R + row] = (bf16_t)(__float_as_uint(gq) >> 16);
                        }
                    ss += __shfl_xor(ss, 16); ss += __shfl_xor(ss, 32);
                    if (fq == 0) VSS[(size_t)row * 16 + ((n0 - 1024) >> 7) * 2 + wc] = ss;
                }
            } else if (n0 < 4096) {
                const bool isq = n0 < 3072;
                const int cb = (isq ? n0 - 2048 : n0 - 3072) + wc * 64;
                if (!isq && ctx) {
                    float* ok = p.out + (size_t)R * D + ((size_t)(b * 4 + l) * 256) * 1024;
#pragma unroll
                    for (int m = 0; m < MI; ++m) {
#pragma unroll
                        for (int n = 0; n < 4; ++n) __builtin_nontemporal_store(acc[m][n], (f32x4*)(ok + (size_t)(pos0 + m * 16 + fr) * 1024 + cb + n * 16 + fq * 4));
                        __builtin_amdgcn_sched_barrier(0);
                    }
                    __builtin_amdgcn_sched_barrier(0);
                }
                if (!ctx) {
                    const float* RC_ = (const float*)(p.ws + O_ROPE);
                    const f32x4 cr = *(const f32x4*)(RC_ + (pos0 >> 6) * 16 + fq * 4), sr = *(const f32x4*)(RC_ + 1024 + (pos0 >> 6) * 16 + fq * 4);
#pragma unroll
                    for (int m = 0; m < MI; ++m) {
                        const int gc = (pos0 & 63) + m * 16 + fr;
                        const f32x4 cc = *(const f32x4*)(RC_ + gc * 16 + fq * 4), sc = *(const f32x4*)(RC_ + 1024 + gc * 16 + fq * 4);
                        const f32x4 x1 = acc[m][0], x2 = acc[m][1], y1 = acc[m][2], y2 = acc[m][3];
                        acc[m][0] = x1 * cr - x2 * sr; acc[m][1] = x2 * cr + x1 * sr;
                        acc[m][2] = y1 * cc - y2 * sc; acc[m][3] = y2 * cc + y1 * sc;
                    }
                }
                bf16_t* dst; size_t rowbase;
                if (isq) { dst = (bf16_t*)(p.ws + O_Q); rowbase = (size_t)(m0 + wr * WMR); }
                else if (ctx) { dst = (bf16_t*)(p.ws + O_KC); rowbase = (size_t)(m0 + wr * WMR); }
                else { dst = (bf16_t*)(p.ws + O_KL); rowbase = (size_t)(l * 2 + b) * 1280 + 256 + pos0; }
                const float qs = isq ? 0.18033688011f : 1.f;
#pragma unroll
                for (int m = 0; m < MI; ++m) {
#pragma unroll
                    for (int n = 0; n < 4; ++n) store_bf4(dst + (rowbase + m * 16 + fr) * 1024 + cb + n * 16 + fq * 4, acc[m][n] * qs);
                    __builtin_amdgcn_sched_barrier(0);
                }
            } else if (n0 < 5120) {
                const int h = (n0 - 4096) >> 7;
                if (ctx) {
                    float* ov = p.out + (size_t)R * D + (size_t)16 * 4 * 256 * 1024 + ((size_t)(b * 4 + l) * 256) * 1024;
#pragma unroll
                    for (int m = 0; m < MI; ++m)
#pragma unroll
                        for (int n = 0; n < 4; ++n) __builtin_nontemporal_store(acc[m][n], (f32x4*)(ov + (size_t)(pos0 + m * 16 + fr) * 1024 + (n0 - 4096) + wc * 64 + n * 16 + fq * 4));
                }
                bf16_t* vt; int ldv, koff;
                if (ctx) { vt = (bf16_t*)(p.ws + O_VTC) + ((size_t)(b * 8 + h) * 128) * 256; ldv = 256; koff = pos0; }
                else { vt = (bf16_t*)(p.ws + O_VTL) + ((size_t)((l * 2 + b) * 8 + h) * 128) * 1280; ldv = 1280; koff = 256 + pos0; }
#pragma unroll
                for (int m = 0; m < MI; ++m)
#pragma unroll
                    for (int n = 0; n < 4; ++n)
#pragma unroll
                        for (int j = 0; j < 4; ++j) {
                            const int e = wc * 64 + n * 16 + fq * 4 + j;
                            vt[(size_t)e * ldv + koff + m * 16 + fr] = (bf16_t)(pk(acc[m][n][j], 0.f) & 0xffffu);
                            if (j == 3) __builtin_amdgcn_sched_barrier(0);
                        }
            } else {
                bf16_t* SG = (bf16_t*)(p.ws + O_SG);
#pragma unroll
                for (int m = 0; m < MI; ++m)
#pragma unroll
                    for (int n = 0; n < 4; ++n) {
                        f32x4 o;
#pragma unroll
                        for (int j = 0; j < 4; ++j) o[j] = sigmoidf_(acc[m][n][j]);
                        store_bf4(SG + (size_t)(m0 + wr * WMR + m * 16 + fr) * 2048 + (n0 - 5120) + wc * 64 + n * 16 + fq * 4, o);
                    }
            }
        }
    }
}

template <int KIND>
__device__ void phase_gemm(const Params& p, int l, int second, unsigned char* lds) {
    const int G = (int)gridDim.x, bid = (int)blockIdx.x;
    if (KIND == G_UP || KIND == G_WIN) {
        const int NTN = (KIND == G_UP) ? 44 : 56, ntiles = 24 * NTN;
        if (KIND == G_WIN && (G & 7) == 0) {
            const int x = bid & 7, lb = bid >> 3, nb = G >> 3, nloc = 24 * 7;
            const int nfull = (nloc / nb) * nb, nrem = nloc - nfull;
            auto ntile_of = [&](int ni) { return ni == 0 ? 16 + x : ni == 1 ? 24 + x : ni == 2 ? 32 + x : ni < 5 ? 2 * x + (ni - 3) : 40 + 2 * x + (ni - 5); };
            for (int j = lb; j < nfull; j += nb) gemm_item<KIND, 4>(p, l, second, (j / 7) * 256, ntile_of(j % 7), lds);
            for (int q = lb; q < nrem * 4; q += nb) { const int j = nfull + (q >> 2); gemm_item<KIND, 1>(p, l, second, (j / 7) * 256 + (q & 3) * 64, ntile_of(j % 7), lds); }
        } else if ((G & 7) == 0) {
            const int x = bid & 7, lb = bid >> 3, nb = G >> 3, mx = x & 3, nx = x >> 2, npx = NTN >> 1, nloc = 6 * npx;
            const int nfull = (nloc / nb) * nb, nrem = nloc - nfull;
            for (int j = lb; j < nfull; j += nb) gemm_item<KIND, 4>(p, l, second, (mx * 6 + j % 6) * 256, nx * npx + j / 6, lds);
            for (int q = lb; q < nrem * 4; q += nb) { const int j = nfull + (q >> 2); gemm_item<KIND, 1>(p, l, second, (mx * 6 + j % 6) * 256 + (q & 3) * 64, nx * npx + j / 6, lds); }
        } else {
            const int nfull = (ntiles / G) * G, nrem = ntiles - nfull;
            for (int t = bid; t < nfull; t += G) gemm_item<KIND, 4>(p, l, second, (t % 24) * 256, t / 24, lds);
            for (int j = bid; j < nrem * 4; j += G) { const int t = nfull + (j >> 2); gemm_item<KIND, 1>(p, l, second, (t % 24) * 256 + (j & 3) * 64, t / 24, lds); }
        }
    } else {
        for (int t = bid; t < 32 * 8; t += G) gemm_item<KIND, 3>(p, l, second, (t % 32) * 192, t / 32, lds);
    }
}

__device__ void spatial_item(const Params& p, int l, int item, unsigned char* lds) {
    const int tid = otid(), wid = tid >> 6, lane = tid & 63, wr = wid >> 2, wc = wid & 3, fr = lane & 15, fq = lane >> 4;
    const int g = item & 3, ck = item >> 2;
    const int m0 = ck * 128, c0 = g * 256;
    const bf16_t* VT = (const bf16_t*)(p.ws + O_VT);
    const float* VSS = (const float*)(p.ws + O_VSS);
    float* rstd = (float*)(lds + LDS_X);
    __syncthreads();
    if (tid < 128) {
        const f32x4* q = (const f32x4*)(VSS + (size_t)(m0 + tid) * 16);
        const f32x4 a = q[0] + q[1] + q[2] + q[3];
        rstd[tid] = __builtin_amdgcn_rsqf((a[0] + a[1] + a[2] + a[3]) * (1.f / 1024.f) + EPS);
    }
    stage_half<4>(lds + 32768, VT + (size_t)c0 * R + m0, R, tid);
    stage_half<4>(lds + 65536, VT + (size_t)c0 * R + m0 + 64, R, tid);
    __syncthreads();
    const float* ws = p.in[13] + (size_t)(l * 4 + g) * 128 * 128;
#pragma unroll
    for (int t = 0; t < 2; ++t)
#pragma unroll
        for (int i = 0; i < 2; ++i) {
            const int b = tid * 16 + i * 8192; int r, c; stage_rc(b, r, c);
            const f32x4 v0 = *(const f32x4*)(ws + r * 128 + t * 64 + c), v1 = *(const f32x4*)(ws + r * 128 + t * 64 + c + 4);
            const float* rs = rstd + t * 64 + c;
            u32x4 w; w.x = pk(v0[0] * rs[0], v0[1] * rs[1]); w.y = pk(v0[2] * rs[2], v0[3] * rs[3]); w.z = pk(v1[0] * rs[4], v1[1] * rs[5]); w.w = pk(v1[2] * rs[6], v1[3] * rs[7]);
            *(u32x4*)(lds + t * 16384 + b) = w;
        }
    WAIT_VM0();
    __syncthreads();
    f32x4 acc[4][4];
#pragma unroll
    for (int m = 0; m < 4; ++m)
#pragma unroll
        for (int n = 0; n < 4; ++n) acc[m][n] = (f32x4){0.f, 0.f, 0.f, 0.f};
    { const unsigned la = lds_addr(lds) + lds_byte(wr * 64 + fr, fq * 8), lb = lds_addr(lds) + 32768 + lds_byte(wc * 64 + fr, fq * 8);
      compute_ktile<4>(la, lb, acc);
      compute_ktile<4>(la + 16384, lb + 32768, acc); }
    const bf16_t* U = (const bf16_t*)(p.ws + O_U);
    bf16_t* ABR = (bf16_t*)(p.ws + O_ABR);
    const float* gain = p.in[12] + (size_t)l * D;
    const float* bs = p.in[14] + (size_t)(l * 4 + g) * 128;
#pragma unroll
    for (int m = 0; m < 4; ++m) {
        const int pr = wr * 64 + m * 16 + fr;
        const float bias = bs[pr];
#pragma unroll
        for (int n = 0; n < 4; ++n) {
            const int col = c0 + wc * 64 + n * 16 + fq * 4;
            const f32x4 gn = *(const f32x4*)(gain + col);
            const u32x2 uv = *(const u32x2*)(U + (size_t)(m0 + pr) * D + col);
            f32x4 u; u[0] = __uint_as_float(uv.x << 16); u[1] = __uint_as_float(uv.x & 0xffff0000u); u[2] = __uint_as_float(uv.y << 16); u[3] = __uint_as_float(uv.y & 0xffff0000u);
            store_bf4(ABR + (size_t)(m0 + pr) * D + col, u * (gn * acc[m][n] + bias));
        }
    }
}

__device__ void attn_item(const Params& p, int l, bool ctx, int b, int h, int qt, unsigned char* lds) {
    const int tid = otid(), wid = tid >> 6, lane = tid & 63, fr = lane & 15, fq = lane >> 4;
    const int qrow0 = (ctx ? b * 256 : RC + b * 1024) + qt * 128 + wid * 16;
    const bf16_t* Kb = ctx ? (const bf16_t*)(p.ws + O_KC) + (size_t)(b * 256) * 1024 + h * 128
                           : (const bf16_t*)(p.ws + O_KL) + ((size_t)(l * 2 + b) * 1280) * 1024 + h * 128;
    const int ldv = ctx ? 256 : 1280;
    const bf16_t* Vb = ctx ? (const bf16_t*)(p.ws + O_VTC) + ((size_t)(b * 8 + h) * 128) * 256
                           : (const bf16_t*)(p.ws + O_VTL) + ((size_t)((l * 2 + b) * 8 + h) * 128) * 1280;
    const int nt = ctx ? 4 : 20;
    const float* lp = p.in[15] + (size_t)l * 256;
    float e1 = lp[lane] * lp[64 + lane], e2 = lp[128 + lane] * lp[192 + lane];
#pragma unroll
    for (int o = 32; o >= 1; o >>= 1) { e1 += __shfl_xor(e1, o); e2 += __shfl_xor(e2, o); }
    const float lam_init = 0.8f - 0.6f * fexp(-0.3f * (float)l);
    const float lam = fexp(e1) - fexp(e2) + lam_init;
    const bf16_t* Q = (const bf16_t*)(p.ws + O_Q) + (size_t)(qrow0 + fr) * 1024 + h * 128;
    bf16x8 qf[2][2];
#pragma unroll
    for (int i2 = 0; i2 < 2; ++i2)
#pragma unroll
        for (int ks = 0; ks < 2; ++ks) qf[i2][ks] = *(const bf16x8*)(Q + i2 * 64 + ks * 32 + fq * 8);
    f32x4 O1[8], O2[8];
#pragma unroll
    for (int e = 0; e < 8; ++e) { O1[e] = (f32x4){0.f, 0.f, 0.f, 0.f}; O2[e] = O1[e]; }
    float mrun[2] = {-1e30f, -1e30f}, lsum[2] = {0.f, 0.f};

    __syncthreads();
#define STAGE_KV(s, t)                                                                                             \
    do {                                                                                                           \
        _Pragma("unroll") for (int i = 0; i < 2; ++i) {                                                            \
            const int P = tid + i * 512;                                                                           \
            const int key = P >> 4, c = (P & 15) ^ (key & 15);                                                     \
            glds16(Kb + (size_t)((t) * 64 + key) * 1024 + c * 8, lds + (s) * 32768 + P * 16);                      \
        }                                                                                                          \
        _Pragma("unroll") for (int i = 0; i < 2; ++i) {                                                            \
            const int P = tid + i * 512;                                                                           \
            const int e = P >> 3, c = (P & 7) ^ ((e >> 1) & 7);                                                    \
            glds16(Vb + (size_t)e * ldv + (t) * 64 + c * 8, lds + (s) * 32768 + 16384 + P * 16);                   \
        }                                                                                                          \
    } while (0)
    unsigned aK[2][2], aV[2][2];
    {
        const unsigned lb0 = lds_addr(lds), sw = (unsigned)(fr >> 1) & 7u;
#pragma unroll
        for (int i2 = 0; i2 < 2; ++i2)
#pragma unroll
            for (int ks = 0; ks < 2; ++ks) aK[i2][ks] = lb0 + fr * 256 + ((((unsigned)(i2 * 8 + ks * 4 + fq)) ^ (unsigned)fr) << 4);
#pragma unroll
        for (int kk = 0; kk < 2; ++kk)
#pragma unroll
            for (int h2 = 0; h2 < 2; ++h2) aV[kk][h2] = lb0 + 16384 + fr * 128 + ((((unsigned)(kk * 4 + (fq >> 1) + 2 * h2)) ^ sw) << 4) + (fq & 1) * 8;
    }
#define LDS_RD64(dst, base, off) asm volatile("ds_read_b64 %0, %1 offset:" #off : "=v"(dst) : "v"(base) : "memory")
    STAGE_KV(0, 0); STAGE_KV(1, 1);
    int cur = 0, nxt = 2;
    for (int t = 0; t < nt; ++t) {
        if (t + 1 < nt) asm volatile("s_waitcnt vmcnt(4)" ::: "memory"); else asm volatile("s_waitcnt vmcnt(0)" ::: "memory");
        __builtin_amdgcn_sched_barrier(0);
        asm volatile("" ::: "memory");
        __builtin_amdgcn_s_barrier();
        asm volatile("" ::: "memory");
        __builtin_amdgcn_sched_barrier(0);
        if (t + 2 < nt) STAGE_KV(nxt, t + 2);
        const unsigned off = (unsigned)cur * 32768u;
        cur = (cur == 2) ? 0 : cur + 1; nxt = (nxt == 2) ? 0 : nxt + 1;
        f32x4 s[2][4];
        {
            bf16x8 kf[2][4][2];
            const unsigned k00 = aK[0][0] + off, k01 = aK[0][1] + off, k10 = aK[1][0] + off, k11 = aK[1][1] + off;
            LDS_RD(kf[0][0][0], k00, 0); LDS_RD(kf[0][0][1], k01, 0); LDS_RD(kf[0][1][0], k00, 4096); LDS_RD(kf[0][1][1], k01, 4096);
            LDS_RD(kf[0][2][0], k00, 8192); LDS_RD(kf[0][2][1], k01, 8192); LDS_RD(kf[0][3][0], k00, 12288); LDS_RD(kf[0][3][1], k01, 12288);
            LDS_RD(kf[1][0][0], k10, 0); LDS_RD(kf[1][0][1], k11, 0); LDS_RD(kf[1][1][0], k10, 4096); LDS_RD(kf[1][1][1], k11, 4096);
            LDS_RD(kf[1][2][0], k10, 8192); LDS_RD(kf[1][2][1], k11, 8192); LDS_RD(kf[1][3][0], k10, 12288); LDS_RD(kf[1][3][1], k11, 12288);
            __builtin_amdgcn_sched_barrier(0);
            asm volatile("s_waitcnt lgkmcnt(8)" ::: "memory");
            __builtin_amdgcn_sched_barrier(0);
#pragma unroll
            for (int kt = 0; kt < 4; ++kt) {
                s[0][kt] = __builtin_amdgcn_mfma_f32_16x16x32_bf16(kf[0][kt][0], qf[0][0], (f32x4){0.f, 0.f, 0.f, 0.f}, 0, 0, 0);
                s[0][kt] = __builtin_amdgcn_mfma_f32_16x16x32_bf16(kf[0][kt][1], qf[0][1], s[0][kt], 0, 0, 0);
            }
            __builtin_amdgcn_sched_barrier(0);
            asm volatile("s_waitcnt lgkmcnt(0)" ::: "memory");
            __builtin_amdgcn_sched_barrier(0);
#pragma unroll
            for (int kt = 0; kt < 4; ++kt) {
                s[1][kt] = __builtin_amdgcn_mfma_f32_16x16x32_bf16(kf[1][kt][0], qf[1][0], (f32x4){0.f, 0.f, 0.f, 0.f}, 0, 0, 0);
                s[1][kt] = __builtin_amdgcn_mfma_f32_16x16x32_bf16(kf[1][kt][1], qf[1][1], s[1][kt], 0, 0, 0);
            }
            __builtin_amdgcn_sched_barrier(0);
        }
        bf16x8 pf[2][2];
#pragma unroll
        for (int i2 = 0; i2 < 2; ++i2) {
            float mx = -1e30f;
#pragma unroll
            for (int kt = 0; kt < 4; ++kt)
#pragma unroll
                for (int j = 0; j < 4; ++j) mx = fmaxf(mx, s[i2][kt][j]);
            if (__builtin_amdgcn_ballot_w64(mx > mrun[i2] + 8.f) != 0) {
                mx = fmaxf(mx, __shfl_xor(mx, 16)); mx = fmaxf(mx, __shfl_xor(mx, 32));
                const float mn = fmaxf(mrun[i2], mx);
                const float alpha = fexp2(mrun[i2] - mn);
                mrun[i2] = mn;
                lsum[i2] *= alpha;
                if (i2 == 0) {
#pragma unroll
                    for (int e = 0; e < 8; ++e) O1[e] = O1[e] * alpha;
                } else {
#pragma unroll
                    for (int e = 0; e < 8; ++e) O2[e] = O2[e] * alpha;
                }
            }
            const float mn = mrun[i2];
            float ps = 0.f;
#pragma unroll
            for (int kt = 0; kt < 4; ++kt)
#pragma unroll
                for (int j = 0; j < 4; ++j) { const float pv = fexp2(s[i2][kt][j] - mn); s[i2][kt][j] = pv; ps += pv; }
            lsum[i2] += ps;
#pragma unroll
            for (int kk = 0; kk < 2; ++kk) {
                u32x4 w;
                w.x = pk(s[i2][2 * kk][0], s[i2][2 * kk][1]); w.y = pk(s[i2][2 * kk][2], s[i2][2 * kk][3]);
                w.z = pk(s[i2][2 * kk + 1][0], s[i2][2 * kk + 1][1]); w.w = pk(s[i2][2 * kk + 1][2], s[i2][2 * kk + 1][3]);
                pf[i2][kk] = __builtin_bit_cast(bf16x8, w);
            }
        }
        {
            const unsigned v00 = aV[0][0] + off, v01 = aV[0][1] + off, v10 = aV[1][0] + off, v11 = aV[1][1] + off;
            u32x2 vl[8][2], vh[8][2];
#define RDV(et, o) do { LDS_RD64(vl[et][0], v00, o); LDS_RD64(vh[et][0], v01, o); LDS_RD64(vl[et][1], v10, o); LDS_RD64(vh[et][1], v11, o); } while (0)
#define PV_STEP(et, WAITN) do { __builtin_amdgcn_sched_barrier(0); asm volatile("s_waitcnt lgkmcnt(" #WAITN ")" ::: "memory"); __builtin_amdgcn_sched_barrier(0); \
            _Pragma("unroll") for (int kk = 0; kk < 2; ++kk) { u32x4 w; w.x = vl[et][kk].x; w.y = vl[et][kk].y; w.z = vh[et][kk].x; w.w = vh[et][kk].y; \
                const bf16x8 vf = __builtin_bit_cast(bf16x8, w); \
                O1[et] = __builtin_amdgcn_mfma_f32_16x16x32_bf16(vf, pf[0][kk], O1[et], 0, 0, 0); O2[et] = __builtin_amdgcn_mfma_f32_16x16x32_bf16(vf, pf[1][kk], O2[et], 0, 0, 0); } \
            __builtin_amdgcn_sched_barrier(0); } while (0)
            RDV(0, 0); RDV(1, 2048); RDV(2, 4096);
            PV_STEP(0, 8); RDV(3, 6144);
            PV_STEP(1, 8); RDV(4, 8192);
            PV_STEP(2, 8); RDV(5, 10240);
            PV_STEP(3, 8); RDV(6, 12288);
            PV_STEP(4, 8); RDV(7, 14336);
            PV_STEP(5, 8);
            PV_STEP(6, 4);
            PV_STEP(7, 0);
#undef PV_STEP
#undef RDV
        }
    }
#undef STAGE_KV
    float l1 = lsum[0], l2 = lsum[1];
    l1 += __shfl_xor(l1, 16); l1 += __shfl_xor(l1, 32);
    l2 += __shfl_xor(l2, 16); l2 += __shfl_xor(l2, 32);
    const float i1 = 1.f / l1, i2s = lam / l2;
    float ss = 0.f;
#pragma unroll
    for (int e = 0; e < 8; ++e) {
        O1[e] = O1[e] * i1 - O2[e] * i2s;
        ss += O1[e][0] * O1[e][0] + O1[e][1] * O1[e][1] + O1[e][2] * O1[e][2] + O1[e][3] * O1[e][3];
    }
    ss += __shfl_xor(ss, 16); ss += __shfl_xor(ss, 32);
    const float rn = __builtin_amdgcn_rsqf(ss * (1.f / 128.f) + EPS) * (1.f - lam_init);
    const float* sg = p.in[16] + (size_t)l * 128;
    bf16_t* BBR = (bf16_t*)(p.ws + O_BBR) + (size_t)(qrow0 + fr) * 1024 + h * 128;
#pragma unroll
    for (int e = 0; e < 8; ++e) {
        const f32x4 gn = *(const f32x4*)(sg + e * 16 + fq * 4);
        store_bf4(BBR + e * 16 + fq * 4, O1[e] * rn * gn);
    }
}

__device__ void phase_mix(const Params& p, int l, unsigned char* lds) {
    constexpr int NQ = 16 + 32 + 24;
    unsigned* ctr = (unsigned*)(p.ws + O_BAR + 14336) + l * 128;
    volatile int* slot = (volatile int*)(lds + LDS_X + 528);
    const int x0 = (int)blockIdx.x & 7;
    bool own_done = false;
    for (;;) {
        __syncthreads();
        if (threadIdx.x == 0) {
            int res = -1;
            if (!own_done) {
                const int k = (int)__hip_atomic_fetch_add(ctr + x0 * 16, 1u, __ATOMIC_RELAXED, __HIP_MEMORY_SCOPE_AGENT);
                if (k < NQ) res = x0 * 256 + k; else own_done = true;
            }
            while (res < 0) {
                unsigned c[8];
#pragma unroll
                for (int j = 0; j < 8; ++j) c[j] = __hip_atomic_load(ctr + j * 16, __ATOMIC_RELAXED, __HIP_MEMORY_SCOPE_AGENT);
                int q = -1;
#pragma unroll
                for (int d = 7; d >= 1; --d) { const int j = (x0 + d) & 7; if (c[j] < (unsigned)NQ) q = j; }
                if (q < 0) break;
                const int k = (int)__hip_atomic_fetch_add(ctr + q * 16, 1u, __ATOMIC_RELAXED, __HIP_MEMORY_SCOPE_AGENT);
                if (k < NQ) res = q * 256 + k;
            }
            *slot = res;
        }
        __syncthreads();
        const int res = *slot;
        if (res < 0) break;
        const int q = res >> 8, k = res & 255;
        if (k < 16) attn_item(p, l, false, k >> 3, q, k & 7, lds);
        else if (k < 48) attn_item(p, l, true, (k - 16) >> 1, q, (k - 16) & 1, lds);
        else spatial_item(p, l, q * 24 + (k - 48), lds);
    }
}

#define XB_TMO      128
#define XB_XCNT(j)  (256  + 64 * (j))
#define XB_XSUB(j)  (1280 + 64 * (j))
#define XB_XGEN(j)  (2304 + 64 * (j))
#define XB_TOP      3328
#define XB_TOPGEN   3392
#define XCD_BAR_WORDS 3456
#define XB_SPIN_CAP (1u << 18)
#define LAS __attribute__((address_space(3)))

__device__ __forceinline__ unsigned xb_ld(unsigned* p)              { return __hip_atomic_load(p, __ATOMIC_RELAXED, __HIP_MEMORY_SCOPE_AGENT); }
__device__ __forceinline__ unsigned xb_add(unsigned* p, unsigned v) { return __hip_atomic_fetch_add(p, v, __ATOMIC_RELAXED, __HIP_MEMORY_SCOPE_AGENT); }
__device__ __forceinline__ unsigned xb_xcc_id() { return (unsigned)__builtin_amdgcn_s_getreg((3 << 11) | 20) & 0xFu; }
#define XB_SPIN(cond, bar) do { unsigned _sp = 0; while (cond) { __builtin_amdgcn_s_sleep(1); \
    if ((++_sp & 255u) == 0u) { if (xb_ld(&(bar)[XB_TMO])) break; if (_sp > XB_SPIN_CAP) { atomicAdd(&(bar)[XB_TMO], 1u); break; } } } } while (0)

struct XcdBarrier {
    unsigned* bar; unsigned x;
    volatile LAS unsigned* st;
};

__device__ __forceinline__ XcdBarrier xcd_barrier_post(unsigned* bar, volatile LAS unsigned* st) {
    XcdBarrier b; b.bar = bar; b.x = xb_xcc_id(); b.st = st;
    if (threadIdx.x == 0) (void)xb_add(&bar[XB_XCNT(b.x)], 1u);
    return b;
}
__device__ __forceinline__ void xcd_barrier_complete(unsigned* bar, unsigned x, unsigned& nloc, unsigned& nx) {
    const unsigned G = gridDim.x * gridDim.y * gridDim.z;
    unsigned sum, cnt, mine, sp = 0u;
    for (;;) {
        sum = 0u; cnt = 0u; mine = 0u;
#pragma unroll
        for (unsigned j = 0; j < 16; ++j) { const unsigned c = xb_ld(&bar[XB_XCNT(j)]); sum += c; cnt += (c > 0u) ? 1u : 0u; mine = (j == x) ? c : mine; }
        if (sum == G) break;
        __builtin_amdgcn_s_sleep(1);
        if ((++sp & 255u) == 0u) { if (xb_ld(&bar[XB_TMO])) break; if (sp > XB_SPIN_CAP) { atomicAdd(&bar[XB_TMO], 1u); break; } }
    }
    nloc = mine > 0u ? mine : 1u; nx = cnt > 0u ? cnt : 1u;
}

__device__ __forceinline__ void xcd_barrier(const XcdBarrier& b) {
    asm volatile("s_waitcnt vmcnt(0)" ::: "memory");
    __syncthreads();
    if (threadIdx.x == 0) {
        unsigned* bar = b.bar;
        __builtin_amdgcn_s_waitcnt(0);
        unsigned nloc = b.st[0], nx = b.st[1];
        if (nloc == 0u) { xcd_barrier_complete(bar, b.x, nloc, nx); b.st[0] = nloc; b.st[1] = nx; }
        const unsigned old = xb_add(&bar[XB_XSUB(b.x)], 1u);
        const unsigned gen = old / nloc;
        if (old + 1u == (gen + 1u) * nloc) {
            __builtin_amdgcn_fence(__ATOMIC_RELEASE, "agent");
            asm volatile("s_waitcnt vmcnt(0)" ::: "memory");
            const unsigned og = xb_add(&bar[XB_TOP], 1u);
            const unsigned tg = og / nx;
            if (og + 1u == (tg + 1u) * nx) xb_add(&bar[XB_TOPGEN], 1u);
            else XB_SPIN(xb_ld(&bar[XB_TOPGEN]) == tg, bar);
            __builtin_amdgcn_fence(__ATOMIC_ACQUIRE, "agent");
            xb_add(&bar[XB_XGEN(b.x)], 1u);
            asm volatile("s_waitcnt vmcnt(0)" ::: "memory");
        } else {
            XB_SPIN(xb_ld(&bar[XB_XGEN(b.x)]) == gen, bar);
            __builtin_amdgcn_fence(__ATOMIC_ACQUIRE, "agent");
            asm volatile("s_waitcnt vmcnt(0)" ::: "memory");
        }
    }
    __syncthreads();
}


constexpr int NPHASE = 46;
__device__ void run_phase(const Params& p, int ph, unsigned char* lds) {
    if (ph == 0) { phase_prologue(p, lds); return; }
    if (ph == NPHASE - 1) { phase_norm(p, 0, 3); return; }
    const int l = (ph - 1) / 11, s = (ph - 1) % 11;
    switch (s) {
        case 0: phase_norm(p, l, 0); break;
        case 1: phase_gemm<G_UP>(p, l, 0, lds); break;
        case 2: phase_gemm<G_DOWN>(p, l, 0, lds); break;
        case 3: phase_norm(p, l, 1); break;
        case 4: phase_gemm<G_WIN>(p, l, 0, lds); break;
        case 5: phase_mix(p, l, lds); break;
        case 6: phase_gemm<G_BR>(p, l, 0, lds); break;
        case 7: phase_gemm<G_OUT>(p, l, 0, lds); break;
        case 8: phase_norm(p, l, 2); break;
        case 9: phase_gemm<G_UP>(p, l, 1, lds); break;
        default: phase_gemm<G_DOWN>(p, l, 1, lds); break;
    }
}

__global__ void __launch_bounds__(NTHR, 2) fwd_kernel(Params p) {
    extern __shared__ __attribute__((aligned(16))) unsigned char lds[];
#if COOP
    cg::grid_group grid = cg::this_grid();
    volatile LAS unsigned* st = (volatile LAS unsigned*)(lds + LDS_X + 512);
    if (threadIdx.x == 0) { st[0] = 0u; st[1] = 0u; st[2] = 0u; st[3] = 0u; }
    __syncthreads();
    XcdBarrier xb = xcd_barrier_post((unsigned*)(p.ws + O_BAR), st);
    for (int ph = p.ph_lo; ph < p.ph_hi; ++ph) {
#ifdef PROBE_DUP
        { const int s_ = (ph == 0) ? 16 : (ph == NPHASE - 1 ? 17 : (ph - 1) % 11);
          const int nrep = ((PROBE_DUP >> s_) & 1) ? 2 : 1;
          for (int rep = 0; rep < nrep; ++rep) { if (rep) xcd_barrier(xb); run_phase(p, ph, lds); }
          if ((PROBE_DUP >> 20) & 1) { xcd_barrier(xb); } }
#else
        run_phase(p, ph, lds);
#endif
        if (ph + 1 < p.ph_hi) { if (p.ph_lo < 0) grid.sync(); else xcd_barrier(xb); }
    }
#else
    for (int ph = p.ph_lo; ph < p.ph_hi; ++ph) run_phase(p, ph, lds);
#endif
}

extern "C" void kernel_launch(void* const* d_in, const int* in_sizes, int n_in, void* d_out, int out_size, void* d_ws, size_t ws_size, hipStream_t stream) {
    static int grid_blocks = 0;
    if (!grid_blocks) {
        int dev = 0, cus = 0, per_cu = 0;
        hipGetDevice(&dev);
        hipDeviceGetAttribute(&cus, hipDeviceAttributeMultiprocessorCount, dev);
        hipFuncSetAttribute((const void*)fwd_kernel, hipFuncAttributeMaxDynamicSharedMemorySize, LDS_BYTES);
        hipOccupancyMaxActiveBlocksPerMultiprocessor(&per_cu, (const void*)fwd_kernel, NTHR, LDS_BYTES);
        if (per_cu < 1) per_cu = 1;
        if (per_cu > 1) per_cu = 1;
        grid_blocks = cus * per_cu;
        if (n_in != 23 || ws_size < WS_END) fprintf(stderr, "kernel_launch: unexpected n_in %d or ws_size %zu (need %zu)\n", n_in, ws_size, (size_t)WS_END);
    }
    Params p{};
    for (int i = 0; i < 23; ++i) p.in[i] = (const float*)d_in[i];
    p.out = (float*)d_out; p.ws = (unsigned char*)d_ws;
#if COOP
    p.ph_lo = 0; p.ph_hi = NPHASE;
    (void)hipMemsetAsync((unsigned char*)d_ws + O_BAR, 0, 16384, stream);
    void* args[] = {&p};
    hipError_t e = hipLaunchCooperativeKernel((const void*)fwd_kernel, dim3(grid_blocks), dim3(NTHR), args, LDS_BYTES, stream);
    if (e != hipSuccess) fprintf(stderr, "cooperative launch failed: %s (grid %d)\n", hipGetErrorString(e), grid_blocks);
#else
    for (int ph = 0; ph < NPHASE; ++ph) {
        p.ph_lo = ph; p.ph_hi = ph + 1;
        hipLaunchKernelGGL(fwd_kernel, dim3(grid_blocks), dim3(NTHR), LDS_BYTES, stream, p);
    }
#endif
}
```
